# Optimizing an MI355X kernel written in HIP

```python
import jax, jax.numpy as jnp
from jax import lax
import numpy as np

D_MODEL = 1024
BATCH = 8
SEQ = 8192
DEPTH = 1
DEC_BATCH = 16
DEC_SEQ = 16
PAST_LEN = 1024

CHUNK = 64
WINDOW = 128
WINDOW_CHUNKS = WINDOW // CHUNK
N_HEADS = 8
N_KV_HEADS = 2
HEAD_DIM = 128
GROUP = N_HEADS // N_KV_HEADS
ATTN_SCALE = HEAD_DIM ** -0.5
D_RNN = D_MODEL
N_RNN_BLOCKS = 8
RNN_BLOCK = D_RNN // N_RNN_BLOCKS
RNN_CONV = 4
RGLRU_C = 8.0
D_FF = ((8 * D_MODEL // 3 + 127) // 128) * 128
FFN_CONV = 3
EPS = 1e-6
Q_W = N_HEADS * HEAD_DIM
KV_W = N_KV_HEADS * HEAD_DIM
IN_W = D_RNN + Q_W + 2 * KV_W + 2 * D_MODEL
SPLITS = [D_RNN, D_RNN + Q_W, D_RNN + Q_W + KV_W, D_RNN + Q_W + 2 * KV_W]

kernel_name = 'hawk_swa_sink_convffn_stream_step'


def rms_norm(x, g):
    xf = x.astype(jnp.float32)
    r = lax.rsqrt(jnp.mean(xf * xf, axis=-1, keepdims=True) + EPS)
    return (xf * r * g.astype(jnp.float32)).astype(x.dtype)


def alibi_slopes():
    return jnp.asarray(np.array([2.0 ** (-8.0 * (h + 1) / N_HEADS) for h in range(N_HEADS)], dtype=np.float32))


def causal_dwconv(x, prev, w, b):
    width = w.shape[0]
    T = x.shape[1]
    xf = jnp.concatenate([prev.astype(x.dtype), x], axis=1)
    y = xf[:, 0:T] * w[0]
    for j in range(1, width):
        y = y + xf[:, j:j + T] * w[j]
    y = y + b
    return y, xf[:, xf.shape[1] - (width - 1):]


def linear_combine(c1, c2):
    a1, b1 = c1
    a2, b2 = c2
    return a1 * a2, a2 * b1 + b2


def rglru(u, h_prev, w_a, b_a, w_x, b_x, lam):
    B, T, _ = u.shape
    ub = u.reshape(B, T, N_RNN_BLOCKS, RNN_BLOCK)
    r = jax.nn.sigmoid((jnp.einsum('btnc,ncd->btnd', ub, w_a).reshape(B, T, D_RNN) + b_a).astype(jnp.float32))
    i = jax.nn.sigmoid((jnp.einsum('btnc,ncd->btnd', ub, w_x).reshape(B, T, D_RNN) + b_x).astype(jnp.float32))
    log_a = -RGLRU_C * r * jax.nn.softplus(-lam.astype(jnp.float32))
    a = jnp.exp(log_a)
    b = jnp.sqrt(-jnp.expm1(2.0 * log_a)) * (i * u.astype(jnp.float32))
    b = b.at[:, 0].add(a[:, 0] * h_prev.astype(jnp.float32))
    _, h = lax.associative_scan(linear_combine, (a, b), axis=1)
    return h.astype(u.dtype), h[:, -1].astype(h_prev.dtype)


def sink_alibi_attention(q, k, v, q_pos, k_pos, k_valid, sinks, slopes):
    B, N, Lq = q.shape[:3]
    qg = q.reshape(B, N, Lq, N_KV_HEADS, GROUP, HEAD_DIM)
    s = jnp.einsum('bnqkgd,bnskd->bnkgqs', qg, k).astype(jnp.float32) * ATTN_SCALE
    dist = jnp.abs(q_pos[:, :, None] - k_pos[:, None, :]).astype(jnp.float32)
    m = slopes.reshape(N_KV_HEADS, GROUP)
    s = s - m[None, None, :, :, None, None] * dist[None, :, None, None, :, :]
    s = jnp.where(k_valid[None, :, None, None, None, :], s, -jnp.inf)
    sink = sinks.astype(jnp.float32).reshape(N_KV_HEADS, GROUP)[None, None, :, :, None, None]
    mx = jnp.maximum(jnp.max(s, axis=-1, keepdims=True), sink)
    p = jnp.exp(s - mx)
    denom = jnp.sum(p, axis=-1, keepdims=True) + jnp.exp(sink - mx)
    p = (p / denom).astype(v.dtype)
    o = jnp.einsum('bnkgqs,bnskd->bnqkgd', p, v)
    return o.reshape(B, N, Lq, N_HEADS * HEAD_DIM)


def banded_window_attention(q, k, v, sinks, slopes):
    B, T = q.shape[:2]
    n_c = T // CHUNK
    pad = WINDOW_CHUNKS * CHUNK
    span = (WINDOW_CHUNKS + 1) * CHUNK

    def blocks(t):
        tp = jnp.pad(t, ((0, 0), (pad, 0), (0, 0), (0, 0))).reshape(B, n_c + WINDOW_CHUNKS, CHUNK, N_KV_HEADS, HEAD_DIM)
        return jnp.concatenate([tp[:, j:j + n_c] for j in range(WINDOW_CHUNKS + 1)], axis=2)

    qb = q.reshape(B, n_c, CHUNK, N_HEADS, HEAD_DIM)
    q_pos = jnp.arange(T, dtype=jnp.int32).reshape(n_c, CHUNK)
    k_pos = jnp.arange(n_c, dtype=jnp.int32)[:, None] * CHUNK - pad + jnp.arange(span, dtype=jnp.int32)[None, :]
    o = sink_alibi_attention(qb, blocks(k), blocks(v), q_pos, k_pos, k_pos >= 0, sinks, slopes)
    return o.reshape(B, T, N_HEADS * HEAD_DIM)


def cached_window_attention(q, k, v, k_cache, v_cache, sinks, slopes):
    S = q.shape[1]
    n_past = k_cache.shape[1]
    k_all = jnp.concatenate([k_cache.astype(k.dtype), k], axis=1)
    v_all = jnp.concatenate([v_cache.astype(v.dtype), v], axis=1)
    q_pos = (PAST_LEN + jnp.arange(S, dtype=jnp.int32))[None]
    k_pos = (PAST_LEN - n_past + jnp.arange(n_past + S, dtype=jnp.int32))[None]
    valid = jnp.ones(k_pos.shape, dtype=bool)
    o = sink_alibi_attention(q[:, None], k_all[:, None], v_all[:, None], q_pos, k_pos, valid, sinks, slopes)
    L = k_all.shape[1]
    return o[:, 0], k_all[:, L - n_past:], v_all[:, L - n_past:]


def hybrid_layer(x, p, slopes, rnn_conv_prev, rnn_h_prev, ffn_conv_prev, k_cache, v_cache):
    B, T, _ = x.shape
    h = rms_norm(x, p['norm_mix_g'])
    u, q, k, v, gl = jnp.split(h @ p['w_in'], SPLITS, axis=-1)
    u, new_rnn_conv = causal_dwconv(u, rnn_conv_prev, p['rnn_conv_w'], p['rnn_conv_b'])
    y_rnn, new_h = rglru(u, rnn_h_prev, p['rnn_gate_a_w'], p['rnn_gate_a_b'], p['rnn_gate_x_w'], p['rnn_gate_x_b'], p['rnn_lambda'])
    q = rms_norm(q.reshape(B, T, N_HEADS, HEAD_DIM), p['q_norm_g'])
    k = rms_norm(k.reshape(B, T, N_KV_HEADS, HEAD_DIM), p['k_norm_g'])
    v = v.reshape(B, T, N_KV_HEADS, HEAD_DIM)
    if k_cache is None:
        y_attn = banded_window_attention(q, k, v, p['attn_sinks'], slopes)
        new_k, new_v = k[:, T - WINDOW:], v[:, T - WINDOW:]
    else:
        y_attn, new_k, new_v = cached_window_attention(q, k, v, k_cache, v_cache, p['attn_sinks'], slopes)
    g_rnn, g_attn = jnp.split(jax.nn.sigmoid(gl + p['b_gate']), 2, axis=-1)
    mixed = g_rnn * (y_rnn @ p['w_rnn_proj']) + g_attn * (y_attn @ p['w_attn_proj'])
    x = x + mixed @ p['w_out']
    h2 = rms_norm(x, p['norm_ffn_g'])
    a, b = jnp.split(h2 @ p['w_up'], 2, axis=-1)
    a, new_ffn_conv = causal_dwconv(a, ffn_conv_prev, p['ffn_conv_w'], p['ffn_conv_b'])
    x = x + (jax.nn.gelu(a, approximate=False) * b) @ p['w_down']
    return x, (new_rnn_conv, new_h, new_k, new_v, new_ffn_conv)


def setup_inputs(seed: int = 0) -> dict:
    key = jax.random.key(seed)
    ks = iter(jax.random.split(key, 40))

    def nrm(shape, scale):
        return jax.random.normal(next(ks), shape, jnp.float32) * scale

    a0 = jax.random.uniform(next(ks), (DEPTH, D_RNN), jnp.float32, minval=0.9, maxval=0.999)
    return {
        'x_prompt': nrm((BATCH, SEQ, D_MODEL), 1.0),
        'x_sample': nrm((DEC_BATCH, DEC_SEQ, D_MODEL), 1.0),
        'state_rnn_conv': nrm((DEPTH, DEC_BATCH, RNN_CONV - 1, D_RNN), 1.0),
        'state_rnn_h': nrm((DEPTH, DEC_BATCH, D_RNN), 0.5),
        'cache_attn_k': nrm((DEPTH, DEC_BATCH, min(WINDOW, PAST_LEN), N_KV_HEADS, HEAD_DIM), 1.0),
        'cache_attn_v': nrm((DEPTH, DEC_BATCH, min(WINDOW, PAST_LEN), N_KV_HEADS, HEAD_DIM), 1.0),
        'state_ffn_conv': nrm((DEPTH, DEC_BATCH, FFN_CONV - 1, D_FF), 1.0),
        'norm_mix_g': 1.0 + nrm((DEPTH, D_MODEL), 0.02),
        'w_in': nrm((DEPTH, D_MODEL, IN_W), D_MODEL ** -0.5),
        'b_gate': nrm((DEPTH, 2 * D_MODEL), 0.02),
        'rnn_conv_w': nrm((DEPTH, RNN_CONV, D_RNN), RNN_CONV ** -0.5),
        'rnn_conv_b': nrm((DEPTH, D_RNN), 0.02),
        'rnn_gate_a_w': nrm((DEPTH, N_RNN_BLOCKS, RNN_BLOCK, RNN_BLOCK), RNN_BLOCK ** -0.5),
        'rnn_gate_a_b': nrm((DEPTH, D_RNN), 0.02),
        'rnn_gate_x_w': nrm((DEPTH, N_RNN_BLOCKS, RNN_BLOCK, RNN_BLOCK), RNN_BLOCK ** -0.5),
        'rnn_gate_x_b': nrm((DEPTH, D_RNN), 0.02),
        'rnn_lambda': jnp.log(a0) - jnp.log1p(-a0),
        'q_norm_g': 1.0 + nrm((DEPTH, HEAD_DIM), 0.02),
        'k_norm_g': 1.0 + nrm((DEPTH, HEAD_DIM), 0.02),
        'attn_sinks': nrm((DEPTH, N_HEADS), 0.5),
        'w_rnn_proj': nrm((DEPTH, D_RNN, D_MODEL), D_RNN ** -0.5),
        'w_attn_proj': nrm((DEPTH, Q_W, D_MODEL), Q_W ** -0.5),
        'w_out': nrm((DEPTH, D_MODEL, D_MODEL), D_MODEL ** -0.5),
        'norm_ffn_g': 1.0 + nrm((DEPTH, D_MODEL), 0.02),
        'w_up': nrm((DEPTH, D_MODEL, 2 * D_FF), D_MODEL ** -0.5),
        'ffn_conv_w': nrm((DEPTH, FFN_CONV, D_FF), FFN_CONV ** -0.5),
        'ffn_conv_b': nrm((DEPTH, D_FF), 0.02),
        'w_down': nrm((DEPTH, D_FF, D_MODEL), D_FF ** -0.5),
    }


def reference(x_prompt, x_sample, state_rnn_conv, state_rnn_h, cache_attn_k, cache_attn_v, state_ffn_conv,
              norm_mix_g, w_in, b_gate, rnn_conv_w, rnn_conv_b, rnn_gate_a_w, rnn_gate_a_b, rnn_gate_x_w,
              rnn_gate_x_b, rnn_lambda, q_norm_g, k_norm_g, attn_sinks, w_rnn_proj, w_attn_proj, w_out,
              norm_ffn_g, w_up, ffn_conv_w, ffn_conv_b, w_down):
    B = x_prompt.shape[0]
    dt = x_prompt.dtype
    slopes = alibi_slopes()
    xp, xs = x_prompt, x_sample
    st_p = ([], [], [], [], [])
    st_s = ([], [], [], [], [])
    for l in range(DEPTH):
        p = {
            'norm_mix_g': norm_mix_g[l], 'w_in': w_in[l], 'b_gate': b_gate[l],
            'rnn_conv_w': rnn_conv_w[l], 'rnn_conv_b': rnn_conv_b[l],
            'rnn_gate_a_w': rnn_gate_a_w[l], 'rnn_gate_a_b': rnn_gate_a_b[l],
            'rnn_gate_x_w': rnn_gate_x_w[l], 'rnn_gate_x_b': rnn_gate_x_b[l],
            'rnn_lambda': rnn_lambda[l], 'q_norm_g': q_norm_g[l], 'k_norm_g': k_norm_g[l],
            'attn_sinks': attn_sinks[l], 'w_rnn_proj': w_rnn_proj[l], 'w_attn_proj': w_attn_proj[l],
            'w_out': w_out[l], 'norm_ffn_g': norm_ffn_g[l], 'w_up': w_up[l],
            'ffn_conv_w': ffn_conv_w[l], 'ffn_conv_b': ffn_conv_b[l], 'w_down': w_down[l],
        }
        xp, sp = hybrid_layer(
            xp, p, slopes,
            jnp.zeros((B, RNN_CONV - 1, D_RNN), dt),
            jnp.zeros((B, D_RNN), dt),
            jnp.zeros((B, FFN_CONV - 1, D_FF), dt),
            None, None)
        xs, ss = hybrid_layer(
            xs, p, slopes, state_rnn_conv[l], state_rnn_h[l], state_ffn_conv[l],
            cache_attn_k[l], cache_attn_v[l])
        for j in range(5):
            st_p[j].append(sp[j])
            st_s[j].append(ss[j])
    return (xp, xs,
            jnp.stack(st_p[0]), jnp.stack(st_s[0]),
            jnp.stack(st_p[1]), jnp.stack(st_s[1]),
            jnp.stack(st_p[2]), jnp.stack(st_s[2]),
            jnp.stack(st_p[3]), jnp.stack(st_s[3]),
            jnp.stack(st_p[4]), jnp.stack(st_s[4]))
```

```cpp
#include <hip/hip_runtime.h>
#include <hip/hip_cooperative_groups.h>
#include <cstdio>
#include <cstdint>
namespace cg = cooperative_groups;

#ifndef ONE_LAUNCH
#define ONE_LAUNCH 1
#endif

constexpr int DM = 1024, NBATCH = 8, SEQ = 8192, MP = NBATCH * SEQ, SBATCH = 16, SSEQ = 16, MS = SBATCH * SSEQ, MTOT = MP + MS;
constexpr int NH = 8, NKV = 2, HD = 128, GRP = 4, WIN = 128, CHUNK = 64, NCH = SEQ / CHUNK;
constexpr int INW = 4608, DFF = 2816, UPW = 2 * DFF, NRB = 8, RB = 128;
constexpr float EPS = 1e-6f;
constexpr int PAST = 1024;

constexpr size_t O_YP = 0, O_YS = O_YP + (size_t)MP * DM, O_RCP = O_YS + (size_t)MS * DM, O_RCS = O_RCP + (size_t)NBATCH * 3 * DM,
                 O_HP = O_RCS + (size_t)SBATCH * 3 * DM, O_HS = O_HP + (size_t)NBATCH * DM, O_KP = O_HS + (size_t)SBATCH * DM,
                 O_KS = O_KP + (size_t)NBATCH * WIN * NKV * HD, O_VP = O_KS + (size_t)SBATCH * WIN * NKV * HD, O_VS = O_VP + (size_t)NBATCH * WIN * NKV * HD,
                 O_FCP = O_VS + (size_t)SBATCH * WIN * NKV * HD, O_FCS = O_FCP + (size_t)NBATCH * 2 * DFF, O_END = O_FCS + (size_t)SBATCH * 2 * DFF;

constexpr size_t MiB = 1u << 20;
constexpr size_t WS_WIN = 0, WS_WMIX = WS_WIN + (size_t)INW * DM * 2, WS_WOUT = WS_WMIX + (size_t)2048 * DM * 2, WS_WUP = WS_WOUT + (size_t)DM * DM * 2,
                 WS_WDN = WS_WUP + (size_t)UPW * DM * 2, WS_WG = WS_WDN + (size_t)DM * DFF * 2, WS_WEND = WS_WG + (size_t)NRB * 256 * RB * 2;
static_assert(WS_WEND == 32 * MiB, "weights region");
constexpr size_t WS_BAR = 32 * MiB + 512 * 1024;
constexpr size_t WS_RSS2 = 32 * MiB, WS_CA = 33 * MiB, WS_CB = 37 * MiB, WS_CARRY = 41 * MiB;
constexpr size_t ROWB = (size_t)MTOT * 2;
constexpr size_t WS_BIG = 48 * MiB;
constexpr size_t WS_U = WS_BIG, WS_Q = WS_U + ROWB * 1024, WS_KV = WS_Q + ROWB * 1024, WS_GT = WS_KV + ROWB * 512, WS_YA = WS_GT + ROWB * 2048, WS_BIGEND = WS_YA + ROWB * 1024;
constexpr size_t WS_AB = WS_BIG;
static_assert(WS_BIGEND - WS_BIG == ROWB * UPW, "AB overlay");
constexpr size_t WS_YR = WS_U, WS_MIX = WS_Q;
constexpr size_t WS_XB = WS_BIGEND, WS_UC = WS_U, WS_X1B = WS_XB, WS_END = WS_XB + ROWB * 1024;
constexpr size_t WS_G = WS_BIG;
constexpr size_t WS_HALO = WS_END, WS_FIXA = WS_HALO + 24 * MiB, WS_FIXB = WS_FIXA + 24 * MiB, WS_HALOU = WS_FIXB + 24 * MiB, WS_FIXU = WS_HALOU + 12 * MiB, WS_END2 = WS_FIXU + 12 * MiB;
static_assert(WS_END2 <= 1024 * MiB, "d_ws map must fit 1 GiB");

#define LAS __attribute__((address_space(3)))
typedef unsigned short bf16_t;
typedef short bf16x8 __attribute__((ext_vector_type(8)));
typedef float f32x4 __attribute__((ext_vector_type(4)));
typedef float f32x2 __attribute__((ext_vector_type(2)));
typedef unsigned u32x4 __attribute__((ext_vector_type(4)));
typedef unsigned u32x2 __attribute__((ext_vector_type(2)));

typedef __bf16 bf16x2_t __attribute__((ext_vector_type(2)));
__device__ __forceinline__ unsigned cvt_pk_bf16(float lo, float hi) { const f32x2 v = {lo, hi}; return __builtin_bit_cast(unsigned, __builtin_convertvector(v, bf16x2_t)); }
__device__ __forceinline__ float bf_lo(unsigned w) { return __uint_as_float(w << 16); }
__device__ __forceinline__ float bf_hi(unsigned w) { return __uint_as_float(w & 0xffff0000u); }
__device__ __forceinline__ float bf1(bf16_t b) { return __uint_as_float((unsigned)b << 16); }
__device__ __forceinline__ float sigmoidf_(float v) { return __builtin_amdgcn_rcpf(1.0f + __expf(-v)); }

__device__ __forceinline__ float gelu_f(float v) {
    const float av = fabsf(v), t = __builtin_amdgcn_rcpf(av * 0.2316418882f + 1.0f);
    float q = t * 0.5307027145f + (-0.7265760135f); q = q * t + 0.7107068705f; q = q * t + (-0.142248368f); q = q * t + 0.127414796f; q = q * t;
    const float e = __builtin_amdgcn_exp2f((v * v) * (-0.72134752044f)), m = v * (q * e);
    return v < 0.f ? m : v - m;
}
template <int N> __device__ __forceinline__ float row_ror(float v) { return __builtin_bit_cast(float, __builtin_amdgcn_update_dpp(0, __builtin_bit_cast(int, v), 0x120 + N, 0xf, 0xf, false)); }

namespace pg8 {
#define PG8_LAS __attribute__((address_space(3)))
constexpr int BM = 256, BK = 64, HALF = 128, HTB = HALF * BK * 2  , STAGE_BYTES = 8 * HTB, NXCD = 8, WGM = 8;

__host__ __device__ __forceinline__ int lds_byte(int r, int c) { const int st = (r >> 4) * 2 + (c >> 5), rr = r & 15, cc = c & 31, ob = rr * 64 + cc * 2; return st * 1024 + (ob ^ (((ob >> 9) & 1) << 5)); }
__host__ __device__ __forceinline__ void stage_rc(int b, int& R, int& C) { const int st = b / 1024, sb = b % 1024, swz = sb ^ (((sb >> 9) & 1) << 5); R = (st >> 1) * 16 + swz / 64; C = (st & 1) * 32 + (swz % 64) / 2; }
__host__ __device__ __forceinline__ int perm32(int rho) { const int n = rho >> 4, i = rho & 15; return 8 * (i >> 2) + 4 * n + (i & 3); }

struct Unit { int pm, pn; };
struct Gemm {
    const bf16_t* A; const bf16_t* A2; const bf16_t* Bt; int lda, ldb, K, a2_from, a_col_step;
    const bf16_t* A3 = nullptr; int ksplit = 0;
    __device__ __forceinline__ const char* a3_ptr(const Unit& u) const { return (const char*)(A3 + (size_t)u.pm * BM * lda) - (size_t)ksplit * (BK * 2); }
    __device__ __forceinline__ const char* a_ptr(const Unit& u) const { return (const char*)((u.pn >= a2_from ? A2 : A) + (size_t)u.pm * BM * lda + (size_t)u.pn * a_col_step); }
    __device__ __forceinline__ const char* b_ptr(const Unit& u) const { return (const char*)(Bt + (size_t)u.pn * BM * ldb); }
};

struct StaticOrder {
    int nM, nN, nwg, G, c;
    __host__ __device__ void init(int M, int N, int G_, int c_) { nM = M / BM; nN = N / BM; nwg = nM * nN; G = G_; c = c_; }
    __host__ __device__ bool next(int i, Unit& u) const {
        const long L = (long)i * G + c; if (L >= nwg) return false;
        int wgid = (int)L; { const int q = nwg / NXCD, r = nwg % NXCD, xcd = wgid % NXCD, off = wgid / NXCD; wgid = (xcd < r ? xcd * (q + 1) : r * (q + 1) + (xcd - r) * q) + off; }
        const int nig = WGM * nN, gid = wgid / nig, fm = gid * WGM, gsz = (nM - fm) < WGM ? (nM - fm) : WGM;
        u.pm = fm + ((wgid % nig) % gsz); u.pn = (wgid % nig) / gsz; return true;
    }
    __device__ __forceinline__ void a_ready(const Unit&) const {}
    __device__ __forceinline__ void done(const Unit&) const {}
};
struct PairOrder {
    StaticOrder so;
    __device__ bool next(int j, Unit& u) const { if (!so.next(j >> 1, u)) return false; u.pn += 4 * (j & 1); return true; }
    __device__ __forceinline__ void a_ready(const Unit&) const {}
    __device__ __forceinline__ void done(const Unit&) const {}
};


struct EpiProj {
    static constexpr bool PERM = true, AFTER_DRAIN = false, HAS_MID = false;
    unsigned char* ws; float* out; const float *bgate, *cw, *cb, *st;
    __device__ __forceinline__ void conv_tile(const f32x4 (&acc)[2][2][4][2], const Unit& u, int wr, int wc, int fr, int fq) const {
        const bool samp = u.pm == MP / BM; const int rowb = u.pm * BM + wr * 64 + fr;
        bf16_t* U = (bf16_t*)(ws + WS_UC); float* HALOU = (float*)(ws + WS_HALOU); float* FIXU = (float*)(ws + WS_FIXU);
#pragma unroll
        for (int bj = 0; bj < 2; ++bj)
#pragma unroll
        for (int n = 0; n < 2; ++n) {
            const int c = u.pn * BM + bj * HALF + wc * 32 + 8 * fq + 4 * n;
            const f32x4 w0 = *(const f32x4*)(cw + c), w1 = *(const f32x4*)(cw + DM + c), w2 = *(const f32x4*)(cw + 2 * DM + c), w3 = *(const f32x4*)(cw + 3 * DM + c), bias = *(const f32x4*)(cb + c);
#pragma unroll
            for (int ai = 0; ai < 2; ++ai) {
#pragma unroll
                for (int m = 0; m < 4; ++m) {
                    const int row = rowb + ai * HALF + m * 16; const f32x4 av = acc[ai][bj][m][n], pv = acc[ai][bj][m > 0 ? m - 1 : 0][n];
                    f32x4 p1, p2, p3; bool fix = false;
#pragma unroll
                    for (int e = 0; e < 4; ++e) { p1[e] = row_ror<1>(av[e]); p2[e] = row_ror<2>(av[e]); p3[e] = row_ror<3>(av[e]); }
                    if (samp) {
                        if (fr < 3) { const float* sp = st + (size_t)((row - MP) >> 4) * 3 * DM + c; const f32x4 s0 = *(const f32x4*)sp, s1 = *(const f32x4*)(sp + DM), s2 = *(const f32x4*)(sp + 2 * DM);
                            if (fr == 0) { p1 = s2; p2 = s1; p3 = s0; } else if (fr == 1) { p2 = s2; p3 = s1; } else p3 = s2; }
                    } else if (m > 0) {
#pragma unroll
                        for (int e = 0; e < 4; ++e) { const float q1 = row_ror<1>(pv[e]), q2 = row_ror<2>(pv[e]), q3 = row_ror<3>(pv[e]); if (fr < 1) p1[e] = q1; if (fr < 2) p2[e] = q2; if (fr < 3) p3[e] = q3; }
                    } else if (fr < 3) {
                        if ((row & (SEQ - 1)) < 3) { const f32x4 z = (f32x4){0.f, 0.f, 0.f, 0.f}; if (fr < 1) p1 = z; if (fr < 2) p2 = z; p3 = z; }
                        else fix = true;
                    }
                    if (fix) *(f32x4*)(FIXU + ((size_t)(row >> 6) * 3 + fr) * DM + c) = av;
                    else { const f32x4 y = p3 * w0 + p2 * w1 + p1 * w2 + av * w3 + bias; u32x2 w; w.x = cvt_pk_bf16(y[0], y[1]); w.y = cvt_pk_bf16(y[2], y[3]); *(u32x2*)(U + (size_t)row * DM + c) = w; }
                    if (!samp) {
                        if (m == 3 && fr >= 13) { *(f32x4*)(HALOU + ((size_t)(row >> 6) * 3 + (fr - 13)) * DM + c) = av;
                            if ((row & (SEQ - 1)) >= SEQ - 3) *(f32x4*)(out + O_RCP + ((size_t)(row >> 13) * 3 + (fr - 13)) * DM + c) = av; }
                    } else if (fr >= 13) *(f32x4*)(out + O_RCS + ((size_t)((row - MP) >> 4) * 3 + (fr - 13)) * DM + c) = av;
                }
            }
        }
    }
    __device__ __forceinline__ void operator()(const f32x4 (&acc)[2][2][4][2], const Unit& u, int wr, int wc, int fr, int fq) const {
        const int pn = u.pn; bf16_t* base; int ldc, colt; bool sig = false;
        if (pn < 4) { conv_tile(acc, u, wr, wc, fr, fq); return; }
        if (pn < 8) { base = (bf16_t*)(ws + WS_Q); ldc = 1024; colt = (pn - 4) * 256; }
        else if (pn < 10) { base = (bf16_t*)(ws + WS_KV); ldc = 512; colt = (pn - 8) * 256; } else { base = (bf16_t*)(ws + WS_GT); ldc = 2048; colt = (pn - 10) * 256; sig = true; }
        const int row0 = u.pm * BM + wr * 64 + fr, col0 = colt + wc * 32 + 8 * fq;
        f32x4 bv[2][2];
#pragma unroll
        for (int bj = 0; bj < 2; ++bj)
#pragma unroll
            for (int n = 0; n < 2; ++n) bv[bj][n] = sig ? *(const f32x4*)(bgate + col0 + bj * HALF + 4 * n) : (f32x4){0.f, 0.f, 0.f, 0.f};
#pragma unroll
        for (int ai = 0; ai < 2; ++ai)
#pragma unroll
            for (int m = 0; m < 4; ++m) { bf16_t* rowp = base + (size_t)(row0 + ai * HALF + m * 16) * ldc + col0;
#pragma unroll
                for (int bj = 0; bj < 2; ++bj) { f32x4 v0 = acc[ai][bj][m][0] + bv[bj][0], v1 = acc[ai][bj][m][1] + bv[bj][1];
                    if (sig) {
#pragma unroll
                        for (int e = 0; e < 4; ++e) { v0[e] = sigmoidf_(v0[e]); v1[e] = sigmoidf_(v1[e]); } }
                    u32x4 w; w.x = cvt_pk_bf16(v0[0], v0[1]); w.y = cvt_pk_bf16(v0[2], v0[3]); w.z = cvt_pk_bf16(v1[0], v1[1]); w.w = cvt_pk_bf16(v1[2], v1[3]);
                    *(u32x4*)(rowp + bj * HALF) = w; } }
    }
};
struct EpiUpF {
    static constexpr bool PERM = true, AFTER_DRAIN = false, HAS_MID = false;
    bf16_t* Gb; const float* rss2; const float* cw; const float* cb; const float* st; float* out; float* HALO; float* FIXA; float* FIXB;
    __device__ __forceinline__ void operator()(const f32x4 (&acc)[2][2][4][2], const Unit& u, int wr, int wc, int fr, int fq) const {
        const bool samp = u.pm == MP / BM;
        const int j0 = u.pn * HALF + wc * 32 + 8 * fq, rowb = u.pm * BM + wr * 64 + fr;
        float rs[2][4];
#pragma unroll
        for (int ai = 0; ai < 2; ++ai)
#pragma unroll
            for (int m = 0; m < 4; ++m) rs[ai][m] = rsqrtf(rss2[rowb + ai * HALF + m * 16] * (1.0f / DM) + EPS);
#pragma unroll
        for (int n = 0; n < 2; ++n) {
            const int j = j0 + 4 * n;
            const f32x4 w0 = *(const f32x4*)(cw + j), w1 = *(const f32x4*)(cw + DFF + j), w2 = *(const f32x4*)(cw + 2 * DFF + j), bias = *(const f32x4*)(cb + j);
#pragma unroll
            for (int ai = 0; ai < 2; ++ai) {
                f32x4 av[4], r1[4], r2[4];
#pragma unroll
                for (int m = 0; m < 4; ++m) { av[m] = acc[ai][0][m][n] * rs[ai][m];
#pragma unroll
                    for (int e = 0; e < 4; ++e) { r1[m][e] = row_ror<1>(av[m][e]); r2[m][e] = row_ror<2>(av[m][e]); } }
#pragma unroll
                for (int m = 0; m < 4; ++m) {
                    const int row = rowb + ai * HALF + m * 16;
                    const f32x4 bvv = acc[ai][1][m][n] * rs[ai][m];
                    f32x4 p1 = r1[m], p2 = r2[m]; bool fix = false;
                    if (samp) {
                        if (fr < 2) { const float* sp = st + (size_t)((row - MP) >> 4) * 2 * DFF + j; const f32x4 s0 = *(const f32x4*)sp, s1 = *(const f32x4*)(sp + DFF);
                            if (fr == 0) { p1 = s1; p2 = s0; } else p2 = s1; }
                    } else if (m > 0) { if (fr < 1) p1 = r1[m - 1]; if (fr < 2) p2 = r2[m - 1]; }
                    else if (fr < 2) {
                        if ((row & (SEQ - 1)) < 2) { const f32x4 z = (f32x4){0.f, 0.f, 0.f, 0.f}; if (fr == 0) p1 = z; p2 = z; }
                        else fix = true;
                    }
                    if (fix) { const size_t o = ((size_t)(row >> 6) * 2 + fr) * DFF + j; *(f32x4*)(FIXA + o) = av[m]; *(f32x4*)(FIXB + o) = bvv; }
                    else {
                        const f32x4 y = p2 * w0 + p1 * w1 + av[m] * w2 + bias; f32x4 g;
#pragma unroll
                        for (int e = 0; e < 4; ++e) g[e] = gelu_f(y[e]) * bvv[e];
                        u32x2 w; w.x = cvt_pk_bf16(g[0], g[1]); w.y = cvt_pk_bf16(g[2], g[3]); *(u32x2*)(Gb + (size_t)row * DFF + j) = w;
                    }
                    if (!samp) {
                        if (m == 3 && fr >= 14) { *(f32x4*)(HALO + ((size_t)(row >> 6) * 2 + (fr - 14)) * DFF + j) = av[m];
                            if ((row & (SEQ - 1)) >= SEQ - 2) *(f32x4*)(out + O_FCP + ((size_t)(row >> 13) * 2 + (fr - 14)) * DFF + j) = av[m]; }
                    } else if (fr >= 14) *(f32x4*)(out + O_FCS + ((size_t)((row - MP) >> 4) * 2 + (fr - 14)) * DFF + j) = av[m];
                }
            }
        }
    }
};
struct EpiMix {
    static constexpr bool PERM = true, AFTER_DRAIN = false, HAS_MID = false;
    bf16_t* MIX; const bf16_t* GT;
    __device__ __forceinline__ void operator()(const f32x4 (&acc)[2][2][4][2], const Unit& u, int wr, int wc, int fr, int fq) const {
        const int seg = u.pn >> 2, row0 = u.pm * BM + wr * 64 + fr, col0 = (u.pn & 3) * BM + wc * 32 + 8 * fq;
#pragma unroll
        for (int ai = 0; ai < 2; ++ai)
#pragma unroll
            for (int m = 0; m < 4; ++m) { const int row = row0 + ai * HALF + m * 16; bf16_t* rowp = MIX + (size_t)row * 1024 + col0; const bf16_t* gp = GT + (size_t)row * 2048 + seg * 1024 + col0;
#pragma unroll
                for (int bj = 0; bj < 2; ++bj) { const u32x4 g = *(const u32x4*)(gp + bj * HALF);
                    f32x4 v0 = acc[ai][bj][m][0], v1 = acc[ai][bj][m][1];
                    v0[0] *= bf_lo(g.x); v0[1] *= bf_hi(g.x); v0[2] *= bf_lo(g.y); v0[3] *= bf_hi(g.y); v1[0] *= bf_lo(g.z); v1[1] *= bf_hi(g.z); v1[2] *= bf_lo(g.w); v1[3] *= bf_hi(g.w);
                    if (seg) { const u32x4 p = *(const u32x4*)(rowp + bj * HALF);
                        v0[0] += bf_lo(p.x); v0[1] += bf_hi(p.x); v0[2] += bf_lo(p.y); v0[3] += bf_hi(p.y); v1[0] += bf_lo(p.z); v1[1] += bf_hi(p.z); v1[2] += bf_lo(p.w); v1[3] += bf_hi(p.w); }
                    u32x4 w; w.x = cvt_pk_bf16(v0[0], v0[1]); w.y = cvt_pk_bf16(v0[2], v0[3]); w.z = cvt_pk_bf16(v1[0], v1[1]); w.w = cvt_pk_bf16(v1[2], v1[3]);
                    *(u32x4*)(rowp + bj * HALF) = w; } }
    }
};
struct EpiMix2 {
    static constexpr bool PERM = true, AFTER_DRAIN = false, HAS_MID = true;
    bf16_t* MIX; const bf16_t* GT;
    __device__ __forceinline__ void mid(f32x4 (&acc)[2][2][4][2], const Unit& u, int wr, int wc, int fr, int fq) const {
        const int row0 = u.pm * BM + wr * 64 + fr, col0 = u.pn * BM + wc * 32 + 8 * fq;
#pragma unroll
        for (int ai = 0; ai < 2; ++ai)
#pragma unroll
            for (int m = 0; m < 4; ++m) { const bf16_t* gp = GT + (size_t)(row0 + ai * HALF + m * 16) * 2048 + col0;
#pragma unroll
                for (int bj = 0; bj < 2; ++bj) { const u32x4 gr = *(const u32x4*)(gp + bj * HALF), ga = *(const u32x4*)(gp + 1024 + bj * HALF);
                    const float r[8] = {bf_lo(gr.x), bf_hi(gr.x), bf_lo(gr.y), bf_hi(gr.y), bf_lo(gr.z), bf_hi(gr.z), bf_lo(gr.w), bf_hi(gr.w)};
                    const float q[8] = {bf_lo(ga.x), bf_hi(ga.x), bf_lo(ga.y), bf_hi(ga.y), bf_lo(ga.z), bf_hi(ga.z), bf_lo(ga.w), bf_hi(ga.w)};
#pragma unroll
                    for (int e = 0; e < 4; ++e) { acc[ai][bj][m][0][e] *= r[e] * __builtin_amdgcn_rcpf(fmaxf(q[e], 1e-30f)); acc[ai][bj][m][1][e] *= r[4 + e] * __builtin_amdgcn_rcpf(fmaxf(q[4 + e], 1e-30f)); } }
                if (m & 1) asm volatile("" ::: "memory"); }
    }
    __device__ __forceinline__ void operator()(const f32x4 (&acc)[2][2][4][2], const Unit& u, int wr, int wc, int fr, int fq) const {
        const int row0 = u.pm * BM + wr * 64 + fr, col0 = u.pn * BM + wc * 32 + 8 * fq;
#pragma unroll
        for (int ai = 0; ai < 2; ++ai)
#pragma unroll
            for (int m = 0; m < 4; ++m) { const int row = row0 + ai * HALF + m * 16; const bf16_t* gp = GT + (size_t)row * 2048 + 1024 + col0;
#pragma unroll
                for (int bj = 0; bj < 2; ++bj) { const u32x4 ga = *(const u32x4*)(gp + bj * HALF);
                    const float q[8] = {bf_lo(ga.x), bf_hi(ga.x), bf_lo(ga.y), bf_hi(ga.y), bf_lo(ga.z), bf_hi(ga.z), bf_lo(ga.w), bf_hi(ga.w)}; float v[8];
#pragma unroll
                    for (int e = 0; e < 4; ++e) { v[e] = acc[ai][bj][m][0][e] * fmaxf(q[e], 1e-30f); v[4 + e] = acc[ai][bj][m][1][e] * fmaxf(q[4 + e], 1e-30f); }
                    u32x4 w; w.x = cvt_pk_bf16(v[0], v[1]); w.y = cvt_pk_bf16(v[2], v[3]); w.z = cvt_pk_bf16(v[4], v[5]); w.w = cvt_pk_bf16(v[6], v[7]);
                    *(u32x4*)(MIX + (size_t)row * DM + col0 + bj * HALF) = w; } }
    }
};
struct EpiOut {
    static constexpr bool PERM = true, AFTER_DRAIN = false, HAS_MID = false;
    const float* xp; const float* xs; float* OUTY; bf16_t* X1B; float* rss2;
    __device__ __forceinline__ void operator()(const f32x4 (&acc)[2][2][4][2], const Unit& u, int wr, int wc, int fr, int fq) const {
        const int col0 = u.pn * BM + wc * 32 + 8 * fq;
#pragma unroll
        for (int ai = 0; ai < 2; ++ai)
#pragma unroll
            for (int m = 0; m < 4; ++m) { const int row = u.pm * BM + ai * HALF + wr * 64 + m * 16 + fr;
                const float* xrow = (row < MP) ? xp + (size_t)row * DM : xs + (size_t)(row - MP) * DM; float ss = 0.f;
#pragma unroll
                for (int bj = 0; bj < 2; ++bj) { const int c = col0 + bj * HALF;
                    const f32x4 o0 = *(const f32x4*)(xrow + c) + acc[ai][bj][m][0], o1 = *(const f32x4*)(xrow + c + 4) + acc[ai][bj][m][1];
                    ss += ((o0[0] * o0[0] + o0[1] * o0[1]) + (o0[2] * o0[2] + o0[3] * o0[3])) + ((o1[0] * o1[0] + o1[1] * o1[1]) + (o1[2] * o1[2] + o1[3] * o1[3]));
                    u32x4 w; w.x = cvt_pk_bf16(o0[0], o0[1]); w.y = cvt_pk_bf16(o0[2], o0[3]); w.z = cvt_pk_bf16(o1[0], o1[1]); w.w = cvt_pk_bf16(o1[2], o1[3]); *(u32x4*)(X1B + (size_t)row * DM + c) = w; }
                ss += __shfl_xor(ss, 16); ss += __shfl_xor(ss, 32);
                if (fq == 0) atomicAdd(rss2 + row, ss);
                if (m & 1) asm volatile("" ::: "memory"); }
    }
};
struct EpiDown {
    static constexpr bool PERM = true, AFTER_DRAIN = false, HAS_MID = false;
    float* OUTY; const bf16_t* X1B;
    __device__ __forceinline__ void operator()(const f32x4 (&acc)[2][2][4][2], const Unit& u, int wr, int wc, int fr, int fq) const {
        const int col0 = u.pn * BM + wc * 32 + 8 * fq;
#pragma unroll
        for (int ai = 0; ai < 2; ++ai)
#pragma unroll
            for (int m = 0; m < 4; ++m) { float* orow = OUTY + (size_t)(u.pm * BM + ai * HALF + wr * 64 + m * 16 + fr) * DM + col0;
#pragma unroll
                for (int bj = 0; bj < 2; ++bj) { float* p = orow + bj * HALF; const u32x4 xw = *(const u32x4*)(X1B + (p - OUTY));
                    *(f32x4*)p = (f32x4){bf_lo(xw.x), bf_hi(xw.x), bf_lo(xw.y), bf_hi(xw.y)} + acc[ai][bj][m][0]; *(f32x4*)(p + 4) = (f32x4){bf_lo(xw.z), bf_hi(xw.z), bf_lo(xw.w), bf_hi(xw.w)} + acc[ai][bj][m][1]; }
                if (m & 1) asm volatile("" ::: "memory"); }
    }
};
struct EpiGates {
    static constexpr bool PERM = true, AFTER_DRAIN = false, HAS_MID = false;
    const bf16_t* UC; bf16_t* LA; bf16_t* BV; const float *ba, *bx, *lam;
    __device__ __forceinline__ void operator()(const f32x4 (&acc)[2][2][4][2], const Unit& u, int wr, int wc, int fr, int fq) const {
        const int ch0 = u.pn * RB + wc * 32 + 8 * fq; const unsigned ro0 = (unsigned)(u.pm * BM + wr * 64 + fr) * DM + ch0;
        f32x4 vba[2], vbx[2], vsp[2];
#pragma unroll
        for (int n = 0; n < 2; ++n) { vba[n] = *(const f32x4*)(ba + ch0 + 4 * n); vbx[n] = *(const f32x4*)(bx + ch0 + 4 * n); const f32x4 l = *(const f32x4*)(lam + ch0 + 4 * n);
#pragma unroll
            for (int e = 0; e < 4; ++e) { const float z = -l[e]; vsp[n][e] = -8.0f * ((z > 20.f) ? z : log1pf(__expf(z))); } }
#pragma unroll
        for (int ai = 0; ai < 2; ++ai)
#pragma unroll
            for (int m = 0; m < 4; ++m) { unsigned ro = ro0 + (unsigned)((ai * HALF + m * 16) * DM); asm volatile("" : "+v"(ro));
                const u32x4 ucw = *(const u32x4*)(UC + ro); const float uc[8] = {bf_lo(ucw.x), bf_hi(ucw.x), bf_lo(ucw.y), bf_hi(ucw.y), bf_lo(ucw.z), bf_hi(ucw.z), bf_lo(ucw.w), bf_hi(ucw.w)};
                float la[8], bv[8];
#pragma unroll
                for (int n = 0; n < 2; ++n)
#pragma unroll
                    for (int e = 0; e < 4; ++e) { const float r = sigmoidf_(acc[ai][0][m][n][e] + vba[n][e]), ig = sigmoidf_(acc[ai][1][m][n][e] + vbx[n][e]);
                        const float l_ = r * vsp[n][e], em = 2.0f * l_;
                        const float om = (em > -0.02f) ? -em * (1.0f + em * (0.5f + em * 0.16666667f)) : 1.0f - __expf(em);
                        la[4 * n + e] = l_; bv[4 * n + e] = __builtin_amdgcn_sqrtf(om) * (ig * uc[4 * n + e]); }
                u32x4 w; w.x = cvt_pk_bf16(la[0], la[1]); w.y = cvt_pk_bf16(la[2], la[3]); w.z = cvt_pk_bf16(la[4], la[5]); w.w = cvt_pk_bf16(la[6], la[7]); *(u32x4*)(LA + ro) = w;
                w.x = cvt_pk_bf16(bv[0], bv[1]); w.y = cvt_pk_bf16(bv[2], bv[3]); w.z = cvt_pk_bf16(bv[4], bv[5]); w.w = cvt_pk_bf16(bv[6], bv[7]); *(u32x4*)(BV + ro) = w;
                if (m & 1) asm volatile("" ::: "memory"); }
    }
};

template <class Epi, class Sched, bool ALIGN_EPI = false, bool SP2 = false>
__device__ __forceinline__ void gemm_phase(PG8_LAS unsigned char* lds, const Gemm g, const Sched& S, const Epi& E) {
    const int tid = threadIdx.x, wid = __builtin_amdgcn_readfirstlane(tid >> 6), lane = tid & 63, wr = wid >> 2, wc = wid & 3, fr = lane & 15, fq = lane >> 4;
    int K = g.K; asm volatile("" : "+s"(K)); const int nt = K / BK;
    unsigned voffA[2], voffB[2];
#pragma unroll
    for (int i = 0; i < 2; ++i) { int R, C; stage_rc(tid * 16 + i * 8192, R, C); const int Rb = Epi::PERM ? ((R & ~31) + perm32(R & 31)) : R;
        voffA[i] = (unsigned)(R * g.lda + C) * 2u; voffB[i] = (unsigned)(Rb * g.ldb + C) * 2u; }
    const size_t kstep = (size_t)(BK * 2);
    const size_t hstepA = (size_t)HALF * g.lda * 2, hstepB = (size_t)HALF * g.ldb * 2;
    const unsigned ldsw = (unsigned)wid * 1024u;
    const int aoff = lds_byte(wr * 64 + fr, fq * 8), boff = lds_byte(wc * 32 + fr, fq * 8);
#define PG8_SA(b, h) (((b) * 2 + (h)) * HTB)
#define PG8_SB(b, h) ((4 + (b) * 2 + (h)) * HTB)
#define PG8_STAGE(bufoff, gbase, voff) do { _Pragma("unroll") for (int _i = 0; _i < 2; ++_i) \
        __builtin_amdgcn_global_load_lds((const unsigned*)((const char*)(gbase) + (voff)[_i]), (PG8_LAS unsigned*)(lds + (bufoff) + ldsw + _i * 8192), 16, 0, 0); } while (0)
#define PG8_LDA(dst, b, h) do { _Pragma("unroll") for (int m = 0; m < 4; ++m) _Pragma("unroll") for (int k = 0; k < 2; ++k) dst[m][k] = *(const PG8_LAS bf16x8*)(lds + PG8_SA(b, h) + aoff + m * 2048 + k * 1024); } while (0)
#define PG8_LDB(dst, b, h) do { _Pragma("unroll") for (int n = 0; n < 2; ++n) _Pragma("unroll") for (int k = 0; k < 2; ++k) dst[n][k] = *(const PG8_LAS bf16x8*)(lds + PG8_SB(b, h) + boff + n * 2048 + k * 1024); } while (0)
#define PG8_MMA(ai, bj, At, Bt) do { __builtin_amdgcn_s_setprio(1); _Pragma("unroll") for (int m = 0; m < 4; ++m) _Pragma("unroll") for (int n = 0; n < 2; ++n) _Pragma("unroll") for (int k = 0; k < 2; ++k) \
        acc[ai][bj][m][n] = __builtin_amdgcn_mfma_f32_16x16x32_bf16(Bt[n][k], At[m][k], acc[ai][bj][m][n], 0, 0, 0); __builtin_amdgcn_s_setprio(0); } while (0)
#define PG8_WAIT_V(n) asm volatile("s_waitcnt vmcnt(" #n ")" ::: "memory")
#define PG8_WAIT_L(n) asm volatile("s_waitcnt lgkmcnt(" #n ")" ::: "memory")
#define PG8_BAR __builtin_amdgcn_s_barrier()
#define PG8_SCHED __builtin_amdgcn_sched_barrier(0)
    Unit cur, nxt; int ui = 0;
    if (!S.next(0, cur)) return;
    f32x4 acc[2][2][4][2];
#pragma unroll
    for (int a = 0; a < 2; ++a)
#pragma unroll
        for (int b = 0; b < 2; ++b)
#pragma unroll
            for (int m = 0; m < 4; ++m)
#pragma unroll
                for (int n = 0; n < 2; ++n) acc[a][b][m][n] = (f32x4){0.f, 0.f, 0.f, 0.f};
    bf16x8 At[4][2], B0[2][2], B1[2][2];
    const char* cA = g.a_ptr(cur); const char* cB = g.b_ptr(cur); const char* cA3 = g.ksplit ? g.a3_ptr(cur) : cA;
    S.a_ready(cur);
    if constexpr (SP2) {
        PG8_STAGE(PG8_SB(0, 0), cB, voffB); PG8_STAGE(PG8_SB(0, 1), cB + hstepB, voffB); PG8_STAGE(PG8_SA(0, 0), cA, voffA); PG8_STAGE(PG8_SA(0, 1), cA + hstepA, voffA);
        if (wr == 1) PG8_BAR;
        PG8_WAIT_V(2); PG8_BAR;
        PG8_STAGE(PG8_SB(1, 0), cB + kstep, voffB); PG8_STAGE(PG8_SA(1, 0), cA + kstep, voffA); PG8_STAGE(PG8_SB(1, 1), cB + hstepB + kstep, voffB);
        PG8_WAIT_V(6); PG8_BAR;
    } else {
        PG8_STAGE(PG8_SB(0, 0), cB, voffB); PG8_STAGE(PG8_SA(0, 0), cA, voffA); PG8_STAGE(PG8_SB(0, 1), cB + hstepB, voffB); PG8_STAGE(PG8_SA(0, 1), cA + hstepA, voffA);
        if (wr == 1) PG8_BAR;
        PG8_WAIT_V(4); PG8_BAR;
        PG8_STAGE(PG8_SB(1, 0), cB + kstep, voffB); PG8_STAGE(PG8_SA(1, 0), cA + kstep, voffA); PG8_STAGE(PG8_SB(1, 1), cB + hstepB + kstep, voffB);
        PG8_WAIT_V(6); PG8_BAR;
    }
    for (;;) {
        const bool has_next = S.next(ui + 1, nxt);
        const char* nA = has_next ? g.a_ptr(nxt) : cA; const char* nB = has_next ? g.b_ptr(nxt) : cB;
        for (int t = 0; t < nt; t += 2) {
            const bool last = (t == nt - 2);
            if constexpr (Epi::HAS_MID) { if (t == g.ksplit) E.mid(acc, cur, wr, wc, fr, fq); }
            const char* a1 = ((g.ksplit && t + 1 >= g.ksplit) ? cA3 : cA) + (size_t)(t + 1) * kstep;
            const char* a2 = last ? nA : ((g.ksplit && t + 2 >= g.ksplit) ? cA3 : cA) + (size_t)(t + 2) * kstep; const char* b2 = last ? nB : cB + (size_t)(t + 2) * kstep;
            const char* a3 = a2 + kstep; const char* b3 = b2 + kstep;
            if (last && has_next) S.a_ready(nxt);
            if constexpr (SP2) {
            PG8_LDB(B0, 0, 0); PG8_LDB(B1, 0, 1); PG8_SCHED; PG8_LDA(At, 0, 0); PG8_STAGE(PG8_SA(1, 1), a1 + hstepA, voffA);
            PG8_WAIT_V(8); PG8_WAIT_L(0); PG8_BAR; PG8_MMA(0, 0, At, B0); PG8_MMA(0, 1, At, B1); PG8_BAR; PG8_SCHED;
            PG8_LDA(At, 0, 1); PG8_STAGE(PG8_SB(0, 0), b2, voffB); PG8_STAGE(PG8_SB(0, 1), b2 + hstepB, voffB); PG8_STAGE(PG8_SA(0, 0), a2, voffA);
            PG8_WAIT_V(8); PG8_WAIT_L(0); PG8_BAR; PG8_MMA(1, 0, At, B0); PG8_MMA(1, 1, At, B1); PG8_BAR; PG8_SCHED;
            PG8_LDB(B0, 1, 0); PG8_LDB(B1, 1, 1); PG8_SCHED; PG8_LDA(At, 1, 0); PG8_STAGE(PG8_SA(0, 1), a2 + hstepA, voffA);
            PG8_WAIT_V(8); PG8_WAIT_L(0); PG8_BAR; PG8_MMA(0, 0, At, B0); PG8_MMA(0, 1, At, B1); PG8_BAR; PG8_SCHED;
            PG8_LDA(At, 1, 1); PG8_STAGE(PG8_SB(1, 0), b3, voffB); PG8_STAGE(PG8_SB(1, 1), b3 + hstepB, voffB); PG8_STAGE(PG8_SA(1, 0), a3, voffA);
            PG8_WAIT_V(8); PG8_WAIT_L(0); PG8_BAR; PG8_MMA(1, 0, At, B0); PG8_MMA(1, 1, At, B1); PG8_BAR; PG8_SCHED;
            } else {
            PG8_LDB(B0, 0, 0); PG8_SCHED; PG8_LDA(At, 0, 0); PG8_STAGE(PG8_SA(1, 1), a1 + hstepA, voffA);
            PG8_WAIT_L(8); PG8_BAR; PG8_WAIT_L(0); PG8_MMA(0, 0, At, B0); PG8_BAR; PG8_SCHED;
            PG8_LDB(B1, 0, 1); PG8_STAGE(PG8_SB(0, 0), b2, voffB);
            PG8_BAR; PG8_WAIT_L(0); PG8_MMA(0, 1, At, B1); PG8_BAR;
            PG8_LDA(At, 0, 1); PG8_STAGE(PG8_SA(0, 0), a2, voffA);
            PG8_BAR; PG8_WAIT_L(0); PG8_MMA(1, 0, At, B0); PG8_BAR; PG8_SCHED;
            PG8_STAGE(PG8_SB(0, 1), b2 + hstepB, voffB);
            PG8_WAIT_V(6); PG8_BAR; PG8_MMA(1, 1, At, B1); PG8_BAR;
            PG8_LDB(B0, 1, 0); PG8_SCHED; PG8_LDA(At, 1, 0); PG8_STAGE(PG8_SA(0, 1), a2 + hstepA, voffA);
            PG8_WAIT_L(8); PG8_BAR; PG8_WAIT_L(0); PG8_MMA(0, 0, At, B0); PG8_BAR; PG8_SCHED;
            PG8_LDB(B1, 1, 1); PG8_STAGE(PG8_SB(1, 0), b3, voffB);
            PG8_BAR; PG8_WAIT_L(0); PG8_MMA(0, 1, At, B1); PG8_BAR;
            PG8_LDA(At, 1, 1); PG8_STAGE(PG8_SA(1, 0), a3, voffA);
            PG8_BAR; PG8_WAIT_L(0); PG8_MMA(1, 0, At, B0); PG8_BAR; PG8_SCHED;
            PG8_STAGE(PG8_SB(1, 1), b3 + hstepB, voffB);
            PG8_WAIT_V(6); PG8_BAR; PG8_MMA(1, 1, At, B1); PG8_BAR;
            }
        }
        if constexpr (ALIGN_EPI) { if (wr == 0) PG8_BAR; }
        if constexpr (!Epi::AFTER_DRAIN) { E(acc, cur, wr, wc, fr, fq); S.done(cur); }
        if (!has_next) break;
#pragma unroll
        for (int a = 0; a < 2; ++a)
#pragma unroll
            for (int b = 0; b < 2; ++b)
#pragma unroll
                for (int m = 0; m < 4; ++m)
#pragma unroll
                    for (int n = 0; n < 2; ++n) acc[a][b][m][n] = (f32x4){0.f, 0.f, 0.f, 0.f};
        cur = nxt; cA = nA; cB = nB; cA3 = g.ksplit ? g.a3_ptr(cur) : cA; ++ui;
        if constexpr (ALIGN_EPI) { if (wr == 1) PG8_BAR; }
    }
    PG8_WAIT_V(0);
    if constexpr (!ALIGN_EPI) { if (wr == 0) PG8_BAR; }
    PG8_BAR;
    if constexpr (Epi::AFTER_DRAIN) { E.fused(acc, cur, wr, wc, fr, fq, lds, wid, lane); S.done(cur); }
#undef PG8_SA
#undef PG8_SB
#undef PG8_STAGE
#undef PG8_LDA
#undef PG8_LDB
#undef PG8_MMA
#undef PG8_WAIT_V
#undef PG8_WAIT_L
#undef PG8_BAR
#undef PG8_SCHED
}
}

#define XB_TMO      128
#define XB_XCNT(j)  (256  + 64 * (j))
#define XB_XSUB(j)  (1280 + 64 * (j))
#define XB_XGEN(j)  (2304 + 64 * (j))
#define XB_TOP      3328
#define XB_TOPGEN   3392
#define XCD_BAR_WORDS 3456
#define XB_SPIN_CAP (1u << 18)

__device__ __forceinline__ unsigned xb_ld(unsigned* p)              { return __hip_atomic_load(p, __ATOMIC_RELAXED, __HIP_MEMORY_SCOPE_AGENT); }
__device__ __forceinline__ unsigned xb_add(unsigned* p, unsigned v) { return __hip_atomic_fetch_add(p, v, __ATOMIC_RELAXED, __HIP_MEMORY_SCOPE_AGENT); }
__device__ __forceinline__ unsigned xb_xcc_id() { return (unsigned)__builtin_amdgcn_s_getreg((3 << 11) | 20) & 0xFu; }
#define XB_SPIN(cond, bar) do { unsigned _sp = 0; while (cond) { __builtin_amdgcn_s_sleep(1); \
    if ((++_sp & 255u) == 0u) { if (xb_ld(&(bar)[XB_TMO])) break; if (_sp > XB_SPIN_CAP) { atomicAdd(&(bar)[XB_TMO], 1u); break; } } } } while (0)

struct XcdBarrier {
    unsigned* bar; unsigned x;
    volatile LAS unsigned* st;
};

__device__ __forceinline__ XcdBarrier xcd_barrier_post(unsigned* bar, volatile LAS unsigned* st) {
    XcdBarrier b; b.bar = bar; b.x = xb_xcc_id(); b.st = st;
    if (threadIdx.x == 0) (void)xb_add(&bar[XB_XCNT(b.x)], 1u);
    return b;
}
__device__ __forceinline__ void xcd_barrier_complete(unsigned* bar, unsigned x, unsigned& nloc, unsigned& nx) {
    const unsigned G = gridDim.x * gridDim.y * gridDim.z;
    unsigned sum, cnt, mine, sp = 0u;
    for (;;) {
        sum = 0u; cnt = 0u; mine = 0u;
#pragma unroll
        for (unsigned j = 0; j < 16; ++j) { const unsigned c = xb_ld(&bar[XB_XCNT(j)]); sum += c; cnt += (c > 0u) ? 1u : 0u; mine = (j == x) ? c : mine; }
        if (sum == G) break;
        __builtin_amdgcn_s_sleep(1);
        if ((++sp & 255u) == 0u) { if (xb_ld(&bar[XB_TMO])) break; if (sp > XB_SPIN_CAP) { atomicAdd(&bar[XB_TMO], 1u); break; } }
    }
    nloc = mine > 0u ? mine : 1u; nx = cnt > 0u ? cnt : 1u;
}

__device__ __forceinline__ void xcd_barrier(const XcdBarrier& b) {
    asm volatile("s_waitcnt vmcnt(0)" ::: "memory");
    __syncthreads();
    if (threadIdx.x == 0) {
        unsigned* bar = b.bar;
        __builtin_amdgcn_s_waitcnt(0);
        unsigned nloc = b.st[0], nx = b.st[1];
        if (nloc == 0u) { xcd_barrier_complete(bar, b.x, nloc, nx); b.st[0] = nloc; b.st[1] = nx; }
        const unsigned old = xb_add(&bar[XB_XSUB(b.x)], 1u);
        const unsigned gen = old / nloc;
        if (old + 1u == (gen + 1u) * nloc) {
            __builtin_amdgcn_fence(__ATOMIC_RELEASE, "agent");
            asm volatile("s_waitcnt vmcnt(0)" ::: "memory");
            const unsigned og = xb_add(&bar[XB_TOP], 1u);
            const unsigned tg = og / nx;
            if (og + 1u == (tg + 1u) * nx) xb_add(&bar[XB_TOPGEN], 1u);
            else XB_SPIN(xb_ld(&bar[XB_TOPGEN]) == tg, bar);
            __builtin_amdgcn_fence(__ATOMIC_ACQUIRE, "agent");
            xb_add(&bar[XB_XGEN(b.x)], 1u);
            asm volatile("s_waitcnt vmcnt(0)" ::: "memory");
        } else {
            XB_SPIN(xb_ld(&bar[XB_XGEN(b.x)]) == gen, bar);
            __builtin_amdgcn_fence(__ATOMIC_ACQUIRE, "agent");
            asm volatile("s_waitcnt vmcnt(0)" ::: "memory");
        }
    }
    __syncthreads();
}

constexpr int NWAVES = 8, NTHR = NWAVES * 64;
constexpr int LDS_BYTES = 147456;
#define LDS_WAIT() asm volatile("s_waitcnt lgkmcnt(0)" ::: "memory")

struct Args {
    const float* in[28]; float* out; unsigned char* ws; int ph_lo, ph_hi;
};
enum { I_XP = 0, I_XS, I_SRC, I_SRH, I_CK, I_CV, I_SFC, I_NMG, I_WIN, I_BG, I_RCW, I_RCB, I_GAW, I_GAB, I_GXW, I_GXB, I_LAM, I_QG, I_KG, I_SINK, I_WRP, I_WAP, I_WOUT, I_NFG, I_WUP, I_FCW, I_FCB, I_WDN };

__device__ __forceinline__ float wave_sum(float v) {
#pragma unroll
    for (int o = 1; o < 64; o <<= 1) v += __shfl_xor(v, o);
    return v;
}
template <bool UPMAP = false> __device__ __forceinline__ void p0_transpose_item(const float* W, int K, int N, bf16_t* WT, int row_off, const float* ks, LAS float* scr, int item, int lane, int ldw = 0, int koff = 0) {
    const int nblk = N / 32, kb = item / nblk, nb = item % nblk, k0 = 64 * kb, n0 = 32 * nb;
#pragma unroll 8
    for (int i = 0; i < 32; ++i) { const int kk = 2 * i + (lane >> 5); float v = W[(size_t)(k0 + kk) * N + n0 + (lane & 31)]; if (ks) v *= ks[k0 + kk]; scr[kk * 33 + (lane & 31)] = v; }
    LDS_WAIT(); asm volatile("" ::: "memory");
    const int c = lane & 7;
#pragma unroll
    for (int j = 0; j < 4; ++j) { const int n = (lane >> 3) + 8 * j; const LAS float* s = scr + (8 * c) * 33 + n;
        u32x4 o; o.x = cvt_pk_bf16(s[0 * 33], s[1 * 33]); o.y = cvt_pk_bf16(s[2 * 33], s[3 * 33]); o.z = cvt_pk_bf16(s[4 * 33], s[5 * 33]); o.w = cvt_pk_bf16(s[6 * 33], s[7 * 33]);
        int orow = row_off + n0 + n;
        if (UPMAP) { const int nn = n0 + n, hf = nn >= DFF ? 1 : 0, jj = nn - hf * DFF; orow = (jj >> 7) * 256 + hf * 128 + (jj & 127); }
        *(u32x4*)(WT + (size_t)orow * (ldw ? ldw : K) + koff + k0 + 8 * c) = o; }
    LDS_WAIT(); asm volatile("" ::: "memory");
}

__device__ __forceinline__ void p0_prologue(const Args& a, LAS unsigned char* lds, int G, bool late) {
    const int tid = threadIdx.x, lane = tid & 63, wave = tid >> 6;
    LAS float* scr = (LAS float*)(lds + wave * 16384);
    const int gw = blockIdx.x * NWAVES + wave, NGW = G * NWAVES;
    unsigned char* ws = a.ws;
    constexpr int T_IN = 16 * (INW / 32), T_SQ = 16 * 32, T_UP = 16 * (UPW / 32), T_DN = (DFF / 64) * 32, T_G = 16 * 8;
    constexpr int NITEMS = T_IN + 3 * T_SQ + T_UP + T_DN + T_G;
    for (int it = (late ? T_IN + T_G : 0) + gw; it < (late ? NITEMS : T_IN + T_G); it += NGW) {
        int r = it;
        if (r < T_IN) { p0_transpose_item(a.in[I_WIN], DM, INW, (bf16_t*)(ws + WS_WIN), 0, nullptr, scr, r, lane); continue; } r -= T_IN;
        if (r < T_G) { const int mat = r >> 3, sub = r & 7, blk = mat >> 1, which = mat & 1;
          p0_transpose_item(a.in[which ? I_GXW : I_GAW] + (size_t)blk * RB * RB, RB, RB, (bf16_t*)(ws + WS_WG) + (size_t)blk * 256 * RB, which * RB, nullptr, scr, sub, lane); continue; } r -= T_G;
        if (r < T_SQ) { p0_transpose_item(a.in[I_WRP], DM, DM, (bf16_t*)(ws + WS_WMIX), 0, nullptr, scr, r, lane, 2048, 0); continue; } r -= T_SQ;
        if (r < T_SQ) { p0_transpose_item(a.in[I_WAP], DM, DM, (bf16_t*)(ws + WS_WMIX), 0, nullptr, scr, r, lane, 2048, 1024); continue; } r -= T_SQ;
        if (r < T_SQ) { p0_transpose_item(a.in[I_WOUT], DM, DM, (bf16_t*)(ws + WS_WOUT), 0, nullptr, scr, r, lane); continue; } r -= T_SQ;
        if (r < T_UP) { p0_transpose_item<true>(a.in[I_WUP], DM, UPW, (bf16_t*)(ws + WS_WUP), 0, a.in[I_NFG], scr, r, lane); continue; } r -= T_UP;
        p0_transpose_item(a.in[I_WDN], DFF, DM, (bf16_t*)(ws + WS_WDN), 0, nullptr, scr, r, lane);
    }
    if (late) return;
    const float* g = a.in[I_NMG];
    f32x4 gv[4];
#pragma unroll
    for (int j = 0; j < 4; ++j) gv[j] = *((const f32x4*)g + lane + 64 * j);
    bf16_t* XB = (bf16_t*)(ws + WS_XB);
    for (int m0 = gw; m0 < MTOT; m0 += 4 * NGW) {
        f32x4 v[4][4];
#pragma unroll
        for (int r = 0; r < 4; ++r) { const int m = m0 + r * NGW; if (m < MTOT) {
            const float* xrow = (m < MP) ? a.in[I_XP] + (size_t)m * DM : a.in[I_XS] + (size_t)(m - MP) * DM; const f32x4* xr = (const f32x4*)xrow + lane;
#pragma unroll
            for (int j = 0; j < 4; ++j) v[r][j] = xr[64 * j]; } }
#pragma unroll
        for (int r = 0; r < 4; ++r) { const int m = m0 + r * NGW; if (m < MTOT) {
            float s = 0.f;
#pragma unroll
            for (int j = 0; j < 4; ++j) s += (v[r][j].x * v[r][j].x + v[r][j].y * v[r][j].y) + (v[r][j].z * v[r][j].z + v[r][j].w * v[r][j].w);
            const float rs = rsqrtf(wave_sum(s) * (1.f / DM) + EPS);
            u32x2* o8 = (u32x2*)(XB + (size_t)m * DM) + lane;
#pragma unroll
            for (int j = 0; j < 4; ++j) { const f32x4 t = v[r][j] * rs * gv[j]; u32x2 w; w.x = cvt_pk_bf16(t.x, t.y); w.y = cvt_pk_bf16(t.z, t.w); o8[64 * j] = w; } } }
    }
    float* rss2 = (float*)(ws + WS_RSS2);
    for (int i = blockIdx.x * NTHR + tid; i < MTOT; i += G * NTHR) rss2[i] = 0.f;
}

__device__ __forceinline__ void conv_fix(const Args& a, int G) {
    bf16_t* UC = (bf16_t*)(a.ws + WS_UC);
    const float* HALOU = (const float*)(a.ws + WS_HALOU); const float* FIXU = (const float*)(a.ws + WS_FIXU);
    const float* cw = a.in[I_RCW]; const float* cb = a.in[I_RCB];
    constexpr int NG4 = DM / 4, NGRP = MP / 64;
    for (int it = blockIdx.x * NTHR + threadIdx.x; it < NGRP * NG4; it += G * NTHR) {
        const int g = it / NG4, c = (it - g * NG4) * 4;
        if ((g & (SEQ / 64 - 1)) == 0) continue;
        const f32x4 w0 = *(const f32x4*)(cw + c), w1 = *(const f32x4*)(cw + DM + c), w2 = *(const f32x4*)(cw + 2 * DM + c), w3 = *(const f32x4*)(cw + 3 * DM + c), bias = *(const f32x4*)(cb + c);
        f32x4 x[6];
#pragma unroll
        for (int k = 0; k < 3; ++k) { x[k] = *(const f32x4*)(HALOU + ((size_t)(g - 1) * 3 + k) * DM + c); x[3 + k] = *(const f32x4*)(FIXU + ((size_t)g * 3 + k) * DM + c); }
#pragma unroll
        for (int k = 0; k < 3; ++k) { const f32x4 y = x[k] * w0 + x[k + 1] * w1 + x[k + 2] * w2 + x[k + 3] * w3 + bias;
            u32x2 w; w.x = cvt_pk_bf16(y[0], y[1]); w.y = cvt_pk_bf16(y[2], y[3]); *(u32x2*)(UC + (size_t)(g * 64 + k) * DM + c) = w; }
    }
}

constexpr int KS_STRIDE = 272, VT_STRIDE = 392;
constexpr int KS_OFF = 0, VT_OFF = 192 * KS_STRIDE;
static_assert(VT_OFF + 128 * VT_STRIDE <= 131072, "attention LDS");

__device__ __forceinline__ void attn_phase(const Args& a, LAS unsigned char* lds, int G, int r_lo, int r_hi) {
    const int tid = threadIdx.x, lane = tid & 63, wave = __builtin_amdgcn_readfirstlane(tid >> 6), fr = lane & 15, fq = lane >> 4;
    const bf16_t* Q = (const bf16_t*)(a.ws + WS_Q); const bf16_t* KV = (const bf16_t*)(a.ws + WS_KV); bf16_t* YA = (bf16_t*)(a.ws + WS_YA);
    const float* qg = a.in[I_QG]; const float* kg = a.in[I_KG]; const float* sinks = a.in[I_SINK];
    constexpr int NPI = NBATCH * NCH * NKV;
    constexpr int NIT = NPI + SBATCH * NKV;
    const int vbid = (G % 8 == 0) ? (int)(blockIdx.x % 8) * (G / 8) + (int)(blockIdx.x / 8) : (int)blockIdx.x;
    for (int item = vbid + r_lo * G; item < NIT && item < vbid + r_hi * G; item += G) {
        const bool samp = item >= NPI;
        int b, c, kvh, kstart, nkeys, kpos0; long rowbase;
        if (!samp) { kvh = item & 1; c = (item >> 1) & (NCH - 1); b = item >> 8; kstart = (c >= 2) ? 0 : (2 - c) * 64; nkeys = 192; kpos0 = (c - 2) * 64; rowbase = (long)b * SEQ + (long)(c - 2) * 64; }
        else { const int si = item - NPI; kvh = si & 1; b = si >> 1; c = 0; kstart = 0; nkeys = 160; kpos0 = PAST - WIN; rowbase = (long)MP + b * SSEQ - 128; }
        const int hl = samp ? wave : (wave >> 1), th = samp ? 0 : (wave & 1), h = kvh * GRP + hl;
        const bool active = !samp || wave < 4;
        u32x4 qraw[2][4];
        const long qr0 = samp ? ((long)MP + b * SSEQ + fr) : ((long)b * SEQ + c * 64 + 32 * th + fr);
#pragma unroll
        for (int ks = 0; ks < 4; ++ks) qraw[0][ks] = active ? *(const u32x4*)(Q + (size_t)qr0 * DM + h * HD + 32 * ks + 8 * fq) : (u32x4){0u, 0u, 0u, 0u};
#pragma unroll
        for (int ks = 0; ks < 4; ++ks) qraw[1][ks] = (active && !samp) ? *(const u32x4*)(Q + (size_t)(qr0 + 16) * DM + h * HD + 32 * ks + 8 * fq) : (u32x4){0u, 0u, 0u, 0u};
        __syncthreads();
        if (!samp) {
            u32x4 kraw[6], vraw[6];
#pragma unroll
            for (int i = 0; i < 6; ++i) { const int ci = tid + i * NTHR, key = ci >> 4, d0 = (ci & 15) * 8;
                if (key >= kstart) { const bf16_t* rp = KV + (size_t)(rowbase + key) * 512 + kvh * HD + d0; kraw[i] = *(const u32x4*)rp; vraw[i] = *(const u32x4*)(rp + 256); }
                else { kraw[i] = (u32x4){0u, 0u, 0u, 0u}; vraw[i] = kraw[i]; } }
            const int d0 = (tid & 15) * 8;
            float kgv[8];
#pragma unroll
            for (int e = 0; e < 8; ++e) kgv[e] = kg[d0 + e];
#pragma unroll
            for (int i = 0; i < 6; ++i) {
                const int key = (tid >> 4) + i * 32; const bool valid = key >= kstart;
                const u32x4 kw = kraw[i], vw = vraw[i];
                float kv[8] = {bf_lo(kw.x), bf_hi(kw.x), bf_lo(kw.y), bf_hi(kw.y), bf_lo(kw.z), bf_hi(kw.z), bf_lo(kw.w), bf_hi(kw.w)};
                float ss = 0.f;
#pragma unroll
                for (int e = 0; e < 8; ++e) ss += kv[e] * kv[e];
                ss += __shfl_xor(ss, 1); ss += __shfl_xor(ss, 2); ss += __shfl_xor(ss, 4); ss += __shfl_xor(ss, 8);
                const float rs = valid ? rsqrtf(ss * (1.f / HD) + EPS) : 0.f;
#pragma unroll
                for (int e = 0; e < 8; ++e) kv[e] = kv[e] * rs * kgv[e];
                u32x4 w; w.x = cvt_pk_bf16(kv[0], kv[1]); w.y = cvt_pk_bf16(kv[2], kv[3]); w.z = cvt_pk_bf16(kv[4], kv[5]); w.w = cvt_pk_bf16(kv[6], kv[7]);
                *(LAS u32x4*)(lds + KS_OFF + key * KS_STRIDE + d0 * 2) = w;
                const unsigned vq[4] = {vw.x, vw.y, vw.z, vw.w};
#pragma unroll
                for (int e = 0; e < 8; ++e) *(LAS bf16_t*)(lds + VT_OFF + (d0 + e) * VT_STRIDE + (key ^ (((d0 >> 3) & 7) << 2)) * 2) = (bf16_t)((e & 1) ? (vq[e >> 1] >> 16) : (vq[e >> 1] & 0xffffu));
                if (c >= NCH - 2 && key >= 128) { const size_t o = (((size_t)b * WIN + (size_t)(c - (NCH - 2)) * 64 + (key - 128)) * NKV + kvh) * HD + d0;
                    *(f32x4*)(a.out + O_KP + o) = (f32x4){kv[0], kv[1], kv[2], kv[3]}; *(f32x4*)(a.out + O_KP + o + 4) = (f32x4){kv[4], kv[5], kv[6], kv[7]};
                    *(f32x4*)(a.out + O_VP + o) = (f32x4){bf_lo(vw.x), bf_hi(vw.x), bf_lo(vw.y), bf_hi(vw.y)}; *(f32x4*)(a.out + O_VP + o + 4) = (f32x4){bf_lo(vw.z), bf_hi(vw.z), bf_lo(vw.w), bf_hi(vw.w)}; }
                asm volatile("" ::: "memory");
            }
        } else {
#pragma unroll
        for (int ii = 0; ii < 5; ++ii) { const int ci = tid + ii * NTHR;
            const int key = ci >> 4, d0 = (ci & 15) * 8;
            float kv[8], vv[8]; bool valid = key < 144, donorm = true;
            if (valid) {
                if (key < 128) { donorm = false;
                    const float* kp = a.in[I_CK] + (((size_t)b * WIN + key) * NKV + kvh) * HD + d0; const float* vp = a.in[I_CV] + (((size_t)b * WIN + key) * NKV + kvh) * HD + d0;
                    const f32x4 k0 = *(const f32x4*)kp, k1 = *(const f32x4*)(kp + 4), v0 = *(const f32x4*)vp, v1 = *(const f32x4*)(vp + 4);
#pragma unroll
                    for (int e = 0; e < 4; ++e) { kv[e] = k0[e]; kv[4 + e] = k1[e]; vv[e] = v0[e]; vv[4 + e] = v1[e]; }
                } else {
                    const bf16_t* rp = KV + (size_t)(rowbase + key) * 512 + kvh * HD + d0;
                    const u32x4 kw = *(const u32x4*)rp, vw = *(const u32x4*)(rp + 256);
                    kv[0] = bf_lo(kw.x); kv[1] = bf_hi(kw.x); kv[2] = bf_lo(kw.y); kv[3] = bf_hi(kw.y); kv[4] = bf_lo(kw.z); kv[5] = bf_hi(kw.z); kv[6] = bf_lo(kw.w); kv[7] = bf_hi(kw.w);
                    vv[0] = bf_lo(vw.x); vv[1] = bf_hi(vw.x); vv[2] = bf_lo(vw.y); vv[3] = bf_hi(vw.y); vv[4] = bf_lo(vw.z); vv[5] = bf_hi(vw.z); vv[6] = bf_lo(vw.w); vv[7] = bf_hi(vw.w);
                }
            } else {
#pragma unroll
                for (int e = 0; e < 8; ++e) { kv[e] = 0.f; vv[e] = 0.f; }
            }
            float ss = 0.f;
#pragma unroll
            for (int e = 0; e < 8; ++e) ss += kv[e] * kv[e];
            ss += __shfl_xor(ss, 1); ss += __shfl_xor(ss, 2); ss += __shfl_xor(ss, 4); ss += __shfl_xor(ss, 8);
            if (valid && donorm) { const float rs = rsqrtf(ss * (1.f / HD) + EPS);
#pragma unroll
                for (int e = 0; e < 8; ++e) kv[e] = kv[e] * rs * kg[d0 + e]; }
            u32x4 w; w.x = cvt_pk_bf16(kv[0], kv[1]); w.y = cvt_pk_bf16(kv[2], kv[3]); w.z = cvt_pk_bf16(kv[4], kv[5]); w.w = cvt_pk_bf16(kv[6], kv[7]);
            *(LAS u32x4*)(lds + KS_OFF + key * KS_STRIDE + d0 * 2) = w;
            u32x4 vw2; vw2.x = cvt_pk_bf16(vv[0], vv[1]); vw2.y = cvt_pk_bf16(vv[2], vv[3]); vw2.z = cvt_pk_bf16(vv[4], vv[5]); vw2.w = cvt_pk_bf16(vv[6], vv[7]);
            const unsigned vq[4] = {vw2.x, vw2.y, vw2.z, vw2.w};
#pragma unroll
            for (int e = 0; e < 8; ++e) *(LAS bf16_t*)(lds + VT_OFF + (d0 + e) * VT_STRIDE + (key ^ (((d0 >> 3) & 7) << 2)) * 2) = (bf16_t)((e & 1) ? (vq[e >> 1] >> 16) : (vq[e >> 1] & 0xffffu));
            if (key >= 16 && key < 144) { const size_t o = (((size_t)b * WIN + (key - 16)) * NKV + kvh) * HD + d0;
                *(f32x4*)(a.out + O_KS + o) = (f32x4){kv[0], kv[1], kv[2], kv[3]}; *(f32x4*)(a.out + O_KS + o + 4) = (f32x4){kv[4], kv[5], kv[6], kv[7]};
                *(f32x4*)(a.out + O_VS + o) = (f32x4){vv[0], vv[1], vv[2], vv[3]}; *(f32x4*)(a.out + O_VS + o + 4) = (f32x4){vv[4], vv[5], vv[6], vv[7]}; }
        }
        }
        __syncthreads();
        if (active) {
            const float slope = exp2f(-(float)(h + 1)) * 1.4426950408889634f, sink = sinks[h] * 1.4426950408889634f;
            const int nt0 = kstart >> 4, ntile = nkeys >> 4;
            const long qrow0 = qr0; const int qpos0 = samp ? (PAST + fr) : (c * 64 + 32 * th + fr);
            bf16x8 qf[2][4];
#pragma unroll
            for (int mt = 0; mt < 2; ++mt) { float qv[4][8]; float ss = 0.f;
#pragma unroll
                for (int ks = 0; ks < 4; ++ks) { const u32x4 w = qraw[mt][ks];
                    qv[ks][0] = bf_lo(w.x); qv[ks][1] = bf_hi(w.x); qv[ks][2] = bf_lo(w.y); qv[ks][3] = bf_hi(w.y); qv[ks][4] = bf_lo(w.z); qv[ks][5] = bf_hi(w.z); qv[ks][6] = bf_lo(w.w); qv[ks][7] = bf_hi(w.w);
#pragma unroll
                    for (int e = 0; e < 8; ++e) ss += qv[ks][e] * qv[ks][e]; }
                ss += __shfl_xor(ss, 16); ss += __shfl_xor(ss, 32);
                const float rs = rsqrtf(ss * (1.f / HD) + EPS) * (0.08838834764831845f * 1.4426950408889634f);
#pragma unroll
                for (int ks = 0; ks < 4; ++ks) { const float* gp = qg + 32 * ks + 8 * fq; float t[8];
#pragma unroll
                    for (int e = 0; e < 8; ++e) t[e] = qv[ks][e] * rs * gp[e];
                    u32x4 w; w.x = cvt_pk_bf16(t[0], t[1]); w.y = cvt_pk_bf16(t[2], t[3]); w.z = cvt_pk_bf16(t[4], t[5]); w.w = cvt_pk_bf16(t[6], t[7]);
                    qf[mt][ks] = __builtin_bit_cast(bf16x8, w); } }
            f32x4 s[2][12]; float mx0 = -INFINITY, mx1 = -INFINITY; const float fb0 = (float)(qpos0 - kpos0 - 4 * fq), fb1 = fb0 + 16.f;
#pragma unroll
            for (int n = 0; n < 12; ++n) {
                s[0][n] = (f32x4){-INFINITY, -INFINITY, -INFINITY, -INFINITY}; s[1][n] = s[0][n];
                if (n >= nt0 && n < ntile) {
                    f32x4 a0 = (f32x4){0.f, 0.f, 0.f, 0.f}, a1 = a0;
#pragma unroll
                    for (int ks = 0; ks < 4; ++ks) { const bf16x8 kf = *(const LAS bf16x8*)(lds + KS_OFF + (16 * n + fr) * KS_STRIDE + (32 * ks + 8 * fq) * 2);
                        a0 = __builtin_amdgcn_mfma_f32_16x16x32_bf16(kf, qf[0][ks], a0, 0, 0, 0); a1 = __builtin_amdgcn_mfma_f32_16x16x32_bf16(kf, qf[1][ks], a1, 0, 0, 0); }
#pragma unroll
                    for (int e = 0; e < 4; ++e) { const float kc = (float)(16 * n + e); float v0 = fmaf(-slope, fabsf(fb0 - kc), a0[e]), v1 = fmaf(-slope, fabsf(fb1 - kc), a1[e]);
                        if (samp && 16 * n + 4 * fq + e >= 144) { v0 = -INFINITY; v1 = -INFINITY; } s[0][n][e] = v0; s[1][n][e] = v1; mx0 = fmaxf(mx0, v0); mx1 = fmaxf(mx1, v1); }
                }
                if ((n & 3) == 3) __builtin_amdgcn_sched_barrier(0);
            }
            mx0 = fmaxf(mx0, __shfl_xor(mx0, 16)); mx0 = fmaxf(mx0, __shfl_xor(mx0, 32)); mx0 = fmaxf(mx0, sink);
            mx1 = fmaxf(mx1, __shfl_xor(mx1, 16)); mx1 = fmaxf(mx1, __shfl_xor(mx1, 32)); mx1 = fmaxf(mx1, sink);
            float sum0 = 0.f, sum1 = 0.f;
#pragma unroll
            for (int n = 0; n < 12; ++n)
#pragma unroll
                for (int e = 0; e < 4; ++e) { const float p0 = __builtin_amdgcn_exp2f(s[0][n][e] - mx0), p1 = __builtin_amdgcn_exp2f(s[1][n][e] - mx1); s[0][n][e] = p0; s[1][n][e] = p1; sum0 += p0; sum1 += p1; }
            sum0 += __shfl_xor(sum0, 16); sum0 += __shfl_xor(sum0, 32); sum1 += __shfl_xor(sum1, 16); sum1 += __shfl_xor(sum1, 32);
            const float inv0 = __builtin_amdgcn_rcpf(sum0 + __builtin_amdgcn_exp2f(sink - mx0)), inv1 = __builtin_amdgcn_rcpf(sum1 + __builtin_amdgcn_exp2f(sink - mx1));
            bf16x8 pf[2][6];
#pragma unroll
            for (int mt = 0; mt < 2; ++mt)
#pragma unroll
                for (int j = 0; j < 6; ++j) { u32x4 w; w.x = cvt_pk_bf16(s[mt][2 * j][0], s[mt][2 * j][1]); w.y = cvt_pk_bf16(s[mt][2 * j][2], s[mt][2 * j][3]);
                    w.z = cvt_pk_bf16(s[mt][2 * j + 1][0], s[mt][2 * j + 1][1]); w.w = cvt_pk_bf16(s[mt][2 * j + 1][2], s[mt][2 * j + 1][3]); pf[mt][j] = __builtin_bit_cast(bf16x8, w); }
#pragma unroll
            for (int dt = 0; dt < 8; ++dt) {
                f32x4 a0 = (f32x4){0.f, 0.f, 0.f, 0.f}, a1 = a0;
#pragma unroll
                for (int j = 0; j < 6; ++j) { if (2 * j >= nt0 && 2 * j < ntile) {
                    const int vsw = ((2 * dt + (fr >> 3)) & 7) << 2;
                    const LAS unsigned char* vp = lds + VT_OFF + (16 * dt + fr) * VT_STRIDE + 64 * j;
                    const u32x2 lo = *(const LAS u32x2*)(vp + ((4 * fq) ^ vsw) * 2), hi = *(const LAS u32x2*)(vp + ((4 * fq + 16) ^ vsw) * 2);
                    u32x4 w; w.x = lo.x; w.y = lo.y; w.z = hi.x; w.w = hi.y; const bf16x8 vf = __builtin_bit_cast(bf16x8, w);
                    a0 = __builtin_amdgcn_mfma_f32_16x16x32_bf16(vf, pf[0][j], a0, 0, 0, 0); a1 = __builtin_amdgcn_mfma_f32_16x16x32_bf16(vf, pf[1][j], a1, 0, 0, 0); } }
                u32x2 w; w.x = cvt_pk_bf16(a0[0] * inv0, a0[1] * inv0); w.y = cvt_pk_bf16(a0[2] * inv0, a0[3] * inv0);
                *(u32x2*)(YA + (size_t)qrow0 * DM + h * HD + 16 * dt + 4 * fq) = w;
                if (!samp) { w.x = cvt_pk_bf16(a1[0] * inv1, a1[1] * inv1); w.y = cvt_pk_bf16(a1[2] * inv1, a1[3] * inv1); *(u32x2*)(YA + (size_t)(qrow0 + 16) * DM + h * HD + 16 * dt + 4 * fq) = w; }
                if (dt & 1) __builtin_amdgcn_sched_barrier(0);
            }
        }
    }
    __syncthreads();
}

__device__ __forceinline__ void scan_agg(const Args& a, int G) {
    const bf16_t* LA = (const bf16_t*)(a.out); const bf16_t* BV = LA + (size_t)MTOT * DM;
    float* CA = (float*)(a.ws + WS_CA); float* CB = (float*)(a.ws + WS_CB);
    const int ch = 2 * threadIdx.x;
    for (int q = blockIdx.x; q < MP / 64; q += G) {
        const unsigned* lp = (const unsigned*)(LA + (size_t)q * 64 * DM + ch); const unsigned* bp = (const unsigned*)(BV + (size_t)q * 64 * DM + ch);
        float s0 = 0.f, s1 = 0.f, h0 = 0.f, h1 = 0.f;
        unsigned lw[64], bw[64];
#pragma unroll
        for (int t = 0; t < 64; ++t) { lw[t] = lp[(size_t)t * (DM / 2)]; bw[t] = bp[(size_t)t * (DM / 2)]; }
#pragma unroll
        for (int t = 0; t < 64; ++t) { const float l0 = bf_lo(lw[t]), l1 = bf_hi(lw[t]); s0 += l0; s1 += l1; h0 = __expf(l0) * h0 + bf_lo(bw[t]); h1 = __expf(l1) * h1 + bf_hi(bw[t]); }
        *(f32x2*)(CA + (size_t)q * DM + ch) = (f32x2){s0, s1}; *(f32x2*)(CB + (size_t)q * DM + ch) = (f32x2){h0, h1};
    }
}
__device__ __forceinline__ void scan_carry(const Args& a, int G) {
    const float* CA = (const float*)(a.ws + WS_CA); const float* CB = (const float*)(a.ws + WS_CB); float* CR = (float*)(a.ws + WS_CARRY);
    for (int i = blockIdx.x * NTHR + threadIdx.x; i < NBATCH * DM; i += G * NTHR) {
        const int b = i >> 10, ch = i & 1023; float carry = 0.f;
#pragma unroll 8
        for (int c = 0; c < NCH; ++c) { const size_t o = (size_t)(b * NCH + c) * DM + ch; CR[o] = carry; carry = __expf(CA[o]) * carry + CB[o]; }
        a.out[O_HP + (size_t)b * DM + ch] = carry;
    }
}
__device__ __forceinline__ void scan_full(const Args& a, int G) {
    const bf16_t* LA = (const bf16_t*)(a.out); const bf16_t* BV = LA + (size_t)MTOT * DM;
    const float* CR = (const float*)(a.ws + WS_CARRY); bf16_t* YR = (bf16_t*)(a.ws + WS_YR);
    const int ch = 2 * threadIdx.x;
    for (int q = blockIdx.x; q < MP / 64 + SBATCH; q += G) {
        const bool samp = q >= MP / 64; const int sb = q - MP / 64;
        const size_t row0 = samp ? (size_t)MP + (size_t)sb * SSEQ : (size_t)q * 64; const int n = samp ? SSEQ : 64;
        const unsigned* lp = (const unsigned*)(LA + row0 * DM + ch); const unsigned* bp = (const unsigned*)(BV + row0 * DM + ch); unsigned* yp = (unsigned*)(YR + row0 * DM + ch);
        f32x2 h = samp ? *(const f32x2*)(a.in[I_SRH] + (size_t)sb * DM + ch) : *(const f32x2*)(CR + (size_t)q * DM + ch);
        if (!samp) {
            unsigned lw[64], bw[64];
#pragma unroll
            for (int t = 0; t < 64; ++t) { lw[t] = lp[(size_t)t * (DM / 2)]; bw[t] = bp[(size_t)t * (DM / 2)]; }
#pragma unroll
            for (int t = 0; t < 64; ++t) { h.x = __expf(bf_lo(lw[t])) * h.x + bf_lo(bw[t]); h.y = __expf(bf_hi(lw[t])) * h.y + bf_hi(bw[t]); yp[(size_t)t * (DM / 2)] = cvt_pk_bf16(h.x, h.y); }
        } else {
#pragma unroll
            for (int t = 0; t < SSEQ; ++t) { const unsigned lw = lp[(size_t)t * (DM / 2)], bw = bp[(size_t)t * (DM / 2)];
                h.x = __expf(bf_lo(lw)) * h.x + bf_lo(bw); h.y = __expf(bf_hi(lw)) * h.y + bf_hi(bw); yp[(size_t)t * (DM / 2)] = cvt_pk_bf16(h.x, h.y); }
        }
        if (samp) *(f32x2*)(a.out + O_HS + (size_t)sb * DM + ch) = h;
    }
}

__device__ __forceinline__ void ffn_fix(const Args& a, int G) {
    bf16_t* Gb = (bf16_t*)(a.ws + WS_G);
    const float* HALO = (const float*)(a.ws + WS_HALO); const float* FIXA = (const float*)(a.ws + WS_FIXA); const float* FIXB = (const float*)(a.ws + WS_FIXB);
    const float* cw = a.in[I_FCW]; const float* cb = a.in[I_FCB];
    constexpr int NG4 = DFF / 4, NGRP = MP / 64;
    for (int it = blockIdx.x * NTHR + threadIdx.x; it < NGRP * NG4; it += G * NTHR) {
        const int g = it / NG4, j = (it - g * NG4) * 4;
        if ((g & (SEQ / 64 - 1)) == 0) continue;
        const f32x4 w0 = *(const f32x4*)(cw + j), w1 = *(const f32x4*)(cw + DFF + j), w2 = *(const f32x4*)(cw + 2 * DFF + j), bias = *(const f32x4*)(cb + j);
        const f32x4 h0 = *(const f32x4*)(HALO + ((size_t)(g - 1) * 2 + 0) * DFF + j), h1 = *(const f32x4*)(HALO + ((size_t)(g - 1) * 2 + 1) * DFF + j);
        const f32x4 a0 = *(const f32x4*)(FIXA + ((size_t)g * 2 + 0) * DFF + j), a1 = *(const f32x4*)(FIXA + ((size_t)g * 2 + 1) * DFF + j);
        const f32x4 b0 = *(const f32x4*)(FIXB + ((size_t)g * 2 + 0) * DFF + j), b1 = *(const f32x4*)(FIXB + ((size_t)g * 2 + 1) * DFF + j);
        const f32x4 y0 = h0 * w0 + h1 * w1 + a0 * w2 + bias, y1 = h1 * w0 + a0 * w1 + a1 * w2 + bias; f32x4 g0, g1;
#pragma unroll
        for (int e = 0; e < 4; ++e) { g0[e] = gelu_f(y0[e]) * b0[e]; g1[e] = gelu_f(y1[e]) * b1[e]; }
        u32x2 w; w.x = cvt_pk_bf16(g0[0], g0[1]); w.y = cvt_pk_bf16(g0[2], g0[3]); *(u32x2*)(Gb + (size_t)(g * 64) * DFF + j) = w;
        w.x = cvt_pk_bf16(g1[0], g1[1]); w.y = cvt_pk_bf16(g1[2], g1[3]); *(u32x2*)(Gb + (size_t)(g * 64 + 1) * DFF + j) = w;
    }
}

template <bool TWO, class F>
__device__ __forceinline__ void thin_tiles(const bf16_t* A0, const bf16_t* B0, const bf16_t* A1, const bf16_t* B1, int lda, int ldb, int K, int G, F&& epi) {
    const int lane = threadIdx.x & 63, wave = threadIdx.x >> 6, fr = lane & 15, fq = lane >> 4;
    constexpr int NTN = DM / 16;
    for (int t = wave * G + blockIdx.x; t < (MS / 16) * NTN; t += NWAVES * G) {
        const int tm = t / NTN, tn = t - tm * NTN, row0 = MP + 16 * tm, col0 = 16 * tn;
        const size_t ao = (size_t)(row0 + fr) * lda + 8 * fq, bo = (size_t)(col0 + fr) * ldb + 8 * fq;
        f32x4 acc0 = (f32x4){0.f, 0.f, 0.f, 0.f}, acc1 = acc0;
        for (int k = 0; k < K; k += 256) {
            bf16x8 av[8], bv[8], av1[8], bv1[8];
#pragma unroll
            for (int i = 0; i < 8; ++i) { av[i] = *(const bf16x8*)(A0 + ao + k + 32 * i); bv[i] = *(const bf16x8*)(B0 + bo + k + 32 * i);
                if (TWO) { av1[i] = *(const bf16x8*)(A1 + ao + k + 32 * i); bv1[i] = *(const bf16x8*)(B1 + bo + k + 32 * i); } }
#pragma unroll
            for (int i = 0; i < 8; ++i) { acc0 = __builtin_amdgcn_mfma_f32_16x16x32_bf16(bv[i], av[i], acc0, 0, 0, 0);
                if (TWO) acc1 = __builtin_amdgcn_mfma_f32_16x16x32_bf16(bv1[i], av1[i], acc1, 0, 0, 0); }
        }
        epi(row0 + fr, col0 + 4 * fq, acc0, acc1);
    }
}

constexpr int NPHASE = 12, ATT_SPLIT = 4;
__global__ void __launch_bounds__(NTHR, 2) hawk_fwd(Args args) {
    extern __shared__ __attribute__((aligned(16))) unsigned char lds_raw[];
    LAS unsigned char* lds = (LAS unsigned char*)lds_raw;
    const int G = gridDim.x, lo = args.ph_lo, hi = args.ph_hi;
    unsigned char* ws = args.ws;
#ifndef ONLY_PHASE
#define ONLY_PHASE -1
#endif
#define IN(k) (lo <= (k) && (k) < hi && (ONLY_PHASE < 0 || ONLY_PHASE == (k)))
    volatile LAS unsigned* bst = (volatile LAS unsigned*)(lds + 131072);
    if (threadIdx.x < 2) bst[threadIdx.x] = 0u;
    __syncthreads();
    const XcdBarrier xbar = xcd_barrier_post((unsigned*)(ws + WS_BAR), bst);
#define SEAM(k) do { if (IN(k) && IN((k) + 1)) { if (hi > NPHASE) cg::this_grid().sync(); else xcd_barrier(xbar); } } while (0)
    if (IN(0)) { p0_prologue(args, lds, G, false); }
    SEAM(0);
    if (IN(1)) {
        pg8::Gemm g{(const bf16_t*)(ws + WS_XB), nullptr, (const bf16_t*)(ws + WS_WIN), DM, DM, DM, 1 << 30, 0};
        pg8::StaticOrder S; S.init(MTOT, INW, G, (int)blockIdx.x);
        pg8::EpiProj E{ws, args.out, args.in[I_BG], args.in[I_RCW], args.in[I_RCB], args.in[I_SRC]};
        pg8::gemm_phase<pg8::EpiProj, pg8::StaticOrder, true, true>(lds, g, S, E);
    }
    SEAM(1);
    if (IN(2)) { conv_fix(args, G); }
    SEAM(2);
    if (IN(3)) {
        pg8::Gemm g{(const bf16_t*)(ws + WS_UC), nullptr, (const bf16_t*)(ws + WS_WG), DM, RB, RB, 1 << 30, RB};
        pg8::StaticOrder S; S.init(MTOT, NRB * 256, G, (int)blockIdx.x);
        bf16_t* LA = (bf16_t*)args.out;
        pg8::EpiGates E{(const bf16_t*)(ws + WS_UC), LA, LA + (size_t)MTOT * DM, args.in[I_GAB], args.in[I_GXB], args.in[I_LAM]};
        if (blockIdx.x & 1) attn_phase(args, lds, G, 0, ATT_SPLIT);
        pg8::gemm_phase<pg8::EpiGates, pg8::StaticOrder, true, true>(lds, g, S, E);
        if (!(blockIdx.x & 1)) attn_phase(args, lds, G, 0, ATT_SPLIT);
    }
    SEAM(3);
    if (IN(4)) scan_agg(args, G);
    SEAM(4);
    if (IN(5)) { scan_carry(args, G); p0_prologue(args, lds, G, true); }
    SEAM(5);
    if (IN(6)) {
        if (blockIdx.x & 1) { attn_phase(args, lds, G, ATT_SPLIT, 1 << 20); scan_full(args, G); } else { scan_full(args, G); attn_phase(args, lds, G, ATT_SPLIT, 1 << 20); }
    }
    SEAM(6);
    if (IN(7)) {
        pg8::Gemm g{(const bf16_t*)(ws + WS_YR), nullptr, (const bf16_t*)(ws + WS_WMIX), DM, 2048, 2048, 1 << 30, 0, (const bf16_t*)(ws + WS_YA), 16};
        { bf16_t* MIX = (bf16_t*)(ws + WS_MIX); const bf16_t* GT = (const bf16_t*)(ws + WS_GT);
          thin_tiles<true>((const bf16_t*)(ws + WS_YR), (const bf16_t*)(ws + WS_WMIX), (const bf16_t*)(ws + WS_YA), (const bf16_t*)(ws + WS_WMIX) + DM, DM, 2048, DM, G,
            [&](int row, int col, const f32x4& a0, const f32x4& a1) { const u32x2 gr = *(const u32x2*)(GT + (size_t)row * 2048 + col), ga = *(const u32x2*)(GT + (size_t)row * 2048 + 1024 + col);
                u32x2 w; w.x = cvt_pk_bf16(bf_lo(gr.x) * a0[0] + bf_lo(ga.x) * a1[0], bf_hi(gr.x) * a0[1] + bf_hi(ga.x) * a1[1]); w.y = cvt_pk_bf16(bf_lo(gr.y) * a0[2] + bf_lo(ga.y) * a1[2], bf_hi(gr.y) * a0[3] + bf_hi(ga.y) * a1[3]);
                *(u32x2*)(MIX + (size_t)row * DM + col) = w; }); }
        pg8::StaticOrder S; S.init(MP, DM, G, (int)blockIdx.x);
        pg8::EpiMix2 E{(bf16_t*)(ws + WS_MIX), (const bf16_t*)(ws + WS_GT)};
        pg8::gemm_phase<pg8::EpiMix2, pg8::StaticOrder, true, true>(lds, g, S, E);
    }
    SEAM(7);
    if (IN(8)) {
        pg8::Gemm g{(const bf16_t*)(ws + WS_MIX), nullptr, (const bf16_t*)(ws + WS_WOUT), DM, DM, DM, 1 << 30, 0};
        { const float* xs = args.in[I_XS]; float* OUTY = args.out; bf16_t* X1B = (bf16_t*)(ws + WS_X1B); float* rss2 = (float*)(ws + WS_RSS2);
          thin_tiles<false>((const bf16_t*)(ws + WS_MIX), (const bf16_t*)(ws + WS_WOUT), nullptr, nullptr, DM, DM, DM, G,
            [&](int row, int col, const f32x4& a0, const f32x4&) { const f32x4 o = *(const f32x4*)(xs + (size_t)(row - MP) * DM + col) + a0;
                u32x2 w; w.x = cvt_pk_bf16(o[0], o[1]); w.y = cvt_pk_bf16(o[2], o[3]); *(u32x2*)(X1B + (size_t)row * DM + col) = w;
                float ss = (o[0] * o[0] + o[1] * o[1]) + (o[2] * o[2] + o[3] * o[3]); ss += __shfl_xor(ss, 16); ss += __shfl_xor(ss, 32); if ((threadIdx.x & 48) == 0) atomicAdd(rss2 + row, ss); }); }
        pg8::StaticOrder S; S.init(MP, DM, G, (int)blockIdx.x);
        pg8::EpiOut E{args.in[I_XP], args.in[I_XS], args.out, (bf16_t*)(ws + WS_X1B), (float*)(ws + WS_RSS2)};
        pg8::gemm_phase<pg8::EpiOut, pg8::StaticOrder, true, true>(lds, g, S, E);
    }
    SEAM(8);
    if (IN(9)) {
        pg8::Gemm g{(const bf16_t*)(ws + WS_X1B), nullptr, (const bf16_t*)(ws + WS_WUP), DM, DM, DM, 1 << 30, 0};
        pg8::StaticOrder S; S.init(MTOT, UPW, G, (int)blockIdx.x);
        pg8::EpiUpF E{(bf16_t*)(ws + WS_G), (const float*)(ws + WS_RSS2), args.in[I_FCW], args.in[I_FCB], args.in[I_SFC], args.out, (float*)(ws + WS_HALO), (float*)(ws + WS_FIXA), (float*)(ws + WS_FIXB)};
        pg8::gemm_phase<pg8::EpiUpF, pg8::StaticOrder, true, true>(lds, g, S, E);
    }
    SEAM(9);
    if (IN(10)) ffn_fix(args, G);
    SEAM(10);
    if (IN(11)) {
        pg8::Gemm g{(const bf16_t*)(ws + WS_G), nullptr, (const bf16_t*)(ws + WS_WDN), DFF, DFF, DFF, 1 << 30, 0};
        { float* OUTY = args.out;
          thin_tiles<false>((const bf16_t*)(ws + WS_G), (const bf16_t*)(ws + WS_WDN), nullptr, nullptr, DFF, DFF, DFF, G,
            [&](int row, int col, const f32x4& a0, const f32x4&) { const u32x2 xw = *(const u32x2*)((const bf16_t*)(ws + WS_X1B) + (size_t)row * DM + col);
                *(f32x4*)(OUTY + (size_t)row * DM + col) = (f32x4){bf_lo(xw.x), bf_hi(xw.x), bf_lo(xw.y), bf_hi(xw.y)} + a0; }); }
        pg8::StaticOrder S; S.init(MP, DM, G, (int)blockIdx.x);
        pg8::EpiDown E{args.out, (const bf16_t*)(ws + WS_X1B)};
        pg8::gemm_phase<pg8::EpiDown, pg8::StaticOrder, true, true>(lds, g, S, E);
    }
#undef IN
#undef SEAM
}

extern "C" void kernel_launch(void* const* d_in, const int* in_sizes, int n_in, void* d_out, int out_size, void* d_ws, size_t ws_size, hipStream_t stream) {
    static int grid = 0;
    if (grid == 0) {
        if (n_in != 28 || (size_t)out_size != O_END || ws_size < WS_END2) { fprintf(stderr, "kernel_launch: unexpected sizes: n_in %d out %d ws %zu (need %zu)\n", n_in, out_size, ws_size, (size_t)WS_END2); grid = -1; return; }
        int dev = 0, cus = 0, per_cu = 0;
        hipGetDevice(&dev); hipDeviceGetAttribute(&cus, hipDeviceAttributeMultiprocessorCount, dev);
        if (hipFuncSetAttribute((const void*)hawk_fwd, hipFuncAttributeMaxDynamicSharedMemorySize, LDS_BYTES) != hipSuccess) { fprintf(stderr, "kernel_launch: hipFuncSetAttribute failed\n"); grid = -1; return; }
        if (hipOccupancyMaxActiveBlocksPerMultiprocessor(&per_cu, (const void*)hawk_fwd, NTHR, LDS_BYTES) != hipSuccess || per_cu < 1) { fprintf(stderr, "kernel_launch: occupancy query says %d\n", per_cu); per_cu = 1; }
        (void)hipGetLastError();
        grid = cus;
    }
    if (grid < 0) return;
    if (hipMemsetAsync((char*)d_ws + WS_BAR, 0, XCD_BAR_WORDS * 4, stream) != hipSuccess) { fprintf(stderr, "kernel_launch: memset failed\n"); return; }
    Args a{};
    for (int i = 0; i < 28; ++i) a.in[i] = (const float*)d_in[i];
    a.out = (float*)d_out; a.ws = (unsigned char*)d_ws;
#if ONE_LAUNCH
    a.ph_lo = 0; a.ph_hi = NPHASE;
    void* kargs[] = {&a};
    hipError_t e = hipLaunchCooperativeKernel((const void*)hawk_fwd, dim3(grid), dim3(NTHR), kargs, LDS_BYTES, stream);
    if (e != hipSuccess) fprintf(stderr, "kernel_launch: cooperative launch failed: %s (grid %d)\n", hipGetErrorString(e), grid);
#else
    for (int p = 0; p < NPHASE; ++p) { a.ph_lo = p; a.ph_hi = p + 1; hipLaunchKernelGGL(hawk_fwd, dim3(grid), dim3(NTHR), LDS_BYTES, stream, a); }
#endif
}
```

```cpp
#include <hip/hip_runtime.h>
#include <hip/hip_cooperative_groups.h>
#include <cstdio>
#include <cstdint>
namespace cg = cooperative_groups;

#ifndef ONE_LAUNCH
#define ONE_LAUNCH 1
#endif

constexpr int DM = 1024, NBATCH = 8, SEQ = 8192, MP = NBATCH * SEQ, SBATCH = 16, SSEQ = 16, MS = SBATCH * SSEQ, MTOT = MP + MS;
constexpr int NH = 8, NKV = 2, HD = 128, GRP = 4, WIN = 128, CHUNK = 64, NCH = SEQ / CHUNK;
constexpr int INW = 4608, DFF = 2816, UPW = 2 * DFF, NRB = 8, RB = 128;
constexpr float EPS = 1e-6f;
constexpr int PAST = 1024;

constexpr size_t O_YP = 0, O_YS = O_YP + (size_t)MP * DM, O_RCP = O_YS + (size_t)MS * DM, O_RCS = O_RCP + (size_t)NBATCH * 3 * DM,
                 O_HP = O_RCS + (size_t)SBATCH * 3 * DM, O_HS = O_HP + (size_t)NBATCH * DM, O_KP = O_HS + (size_t)SBATCH * DM,
                 O_KS = O_KP + (size_t)NBATCH * WIN * NKV * HD, O_VP = O_KS + (size_t)SBATCH * WIN * NKV * HD, O_VS = O_VP + (size_t)NBATCH * WIN * NKV * HD,
                 O_FCP = O_VS + (size_t)SBATCH * WIN * NKV * HD, O_FCS = O_FCP + (size_t)NBATCH * 2 * DFF, O_END = O_FCS + (size_t)SBATCH * 2 * DFF;

constexpr size_t MiB = 1u << 20;
constexpr size_t WS_WIN = 0, WS_WMIX = WS_WIN + (size_t)INW * DM * 2, WS_WOUT = WS_WMIX + (size_t)2048 * DM * 2, WS_WUP = WS_WOUT + (size_t)DM * DM * 2,
                 WS_WDN = WS_WUP + (size_t)UPW * DM * 2, WS_WG = WS_WDN + (size_t)DM * DFF * 2, WS_WEND = WS_WG + (size_t)NRB * 256 * RB * 2;
static_assert(WS_WEND == 32 * MiB, "weights region");
constexpr size_t WS_BAR = 32 * MiB + 512 * 1024;
constexpr size_t WS_RSS2 = 32 * MiB, WS_CA = 33 * MiB, WS_CB = 37 * MiB, WS_CARRY = 41 * MiB;
constexpr size_t ROWB = (size_t)MTOT * 2;
constexpr size_t WS_BIG = 48 * MiB;
constexpr size_t WS_U = WS_BIG, WS_Q = WS_U + ROWB * 1024, WS_KV = WS_Q + ROWB * 1024, WS_GT = WS_KV + ROWB * 512, WS_YA = WS_GT + ROWB * 2048, WS_BIGEND = WS_YA + ROWB * 1024;
constexpr size_t WS_AB = WS_BIG;
static_assert(WS_BIGEND - WS_BIG == ROWB * UPW, "AB overlay");
constexpr size_t WS_YR = WS_U, WS_MIX = WS_Q;
constexpr size_t WS_XB = WS_BIGEND, WS_UC = WS_U, WS_X1B = WS_XB, WS_END = WS_XB + ROWB * 1024;
constexpr size_t WS_G = WS_BIG;
constexpr size_t WS_HALO = WS_END, WS_FIXA = WS_HALO + 24 * MiB, WS_FIXB = WS_FIXA + 24 * MiB, WS_HALOU = WS_FIXB + 24 * MiB, WS_FIXU = WS_HALOU + 12 * MiB, WS_END2 = WS_FIXU + 12 * MiB;
static_assert(WS_END2 <= 1024 * MiB, "d_ws map must fit 1 GiB");

#define LAS __attribute__((address_space(3)))
typedef unsigned short bf16_t;
typedef short bf16x8 __attribute__((ext_vector_type(8)));
typedef float f32x4 __attribute__((ext_vector_type(4)));
typedef float f32x2 __attribute__((ext_vector_type(2)));
typedef unsigned u32x4 __attribute__((ext_vector_type(4)));
typedef unsigned u32x2 __attribute__((ext_vector_type(2)));

typedef __bf16 bf16x2_t __attribute__((ext_vector_type(2)));
__device__ __forceinline__ unsigned cvt_pk_bf16(float lo, float hi) { const f32x2 v = {lo, hi}; return __builtin_bit_cast(unsigned, __builtin_convertvector(v, bf16x2_t)); }
__device__ __forceinline__ float bf_lo(unsigned w) { return __uint_as_float(w << 16); }
__device__ __forceinline__ float bf_hi(unsigned w) { return __uint_as_float(w & 0xffff0000u); }
__device__ __forceinline__ float bf1(bf16_t b) { return __uint_as_float((unsigned)b << 16); }
__device__ __forceinline__ float sigmoidf_(float v) { return __builtin_amdgcn_rcpf(1.0f + __expf(-v)); }

__device__ __forceinline__ float gelu_f(float v) {
    const float av = fabsf(v), t = __builtin_amdgcn_rcpf(av * 0.2316418882f + 1.0f);
    float q = t * 0.5307027145f + (-0.7265760135f); q = q * t + 0.7107068705f; q = q * t + (-0.142248368f); q = q * t + 0.127414796f; q = q * t;
    const float e = __builtin_amdgcn_exp2f((v * v) * (-0.72134752044f)), m = v * (q * e);
    return v < 0.f ? m : v - m;
}
template <int N> __device__ __forceinline__ float row_ror(float v) { return __builtin_bit_cast(float, __builtin_amdgcn_update_dpp(0, __builtin_bit_cast(int, v), 0x120 + N, 0xf, 0xf, false)); }

namespace pg8 {
#define PG8_LAS __attribute__((address_space(3)))
constexpr int BM = 256, BK = 64, HALF = 128, HTB = HALF * BK * 2  , STAGE_BYTES = 8 * HTB, NXCD = 8, WGM = 8;

__host__ __device__ __forceinline__ int lds_byte(int r, int c) { const int st = (r >> 4) * 2 + (c >> 5), rr = r & 15, cc = c & 31, ob = rr * 64 + cc * 2; return st * 1024 + (ob ^ (((ob >> 9) & 1) << 5)); }
__host__ __device__ __forceinline__ void stage_rc(int b, int& R, int& C) { const int st = b / 1024, sb = b % 1024, swz = sb ^ (((sb >> 9) & 1) << 5); R = (st >> 1) * 16 + swz / 64; C = (st & 1) * 32 + (swz % 64) / 2; }
__host__ __device__ __forceinline__ int perm32(int rho) { const int n = rho >> 4, i = rho & 15; return 8 * (i >> 2) + 4 * n + (i & 3); }

struct Unit { int pm, pn; };
struct Gemm {
    const bf16_t* A; const bf16_t* A2; const bf16_t* Bt; int lda, ldb, K, a2_from, a_col_step;
    const bf16_t* A3 = nullptr; int ksplit = 0;
    __device__ __forceinline__ const char* a3_ptr(const Unit& u) const { return (const char*)(A3 + (size_t)u.pm * BM * lda) - (size_t)ksplit * (BK * 2); }
    __device__ __forceinline__ const char* a_ptr(const Unit& u) const { return (const char*)((u.pn >= a2_from ? A2 : A) + (size_t)u.pm * BM * lda + (size_t)u.pn * a_col_step); }
    __device__ __forceinline__ const char* b_ptr(const Unit& u) const { return (const char*)(Bt + (size_t)u.pn * BM * ldb); }
};

struct StaticOrder {
    int nM, nN, nwg, G, c;
    __host__ __device__ void init(int M, int N, int G_, int c_) { nM = M / BM; nN = N / BM; nwg = nM * nN; G = G_; c = c_; }
    __host__ __device__ bool next(int i, Unit& u) const {
        const long L = (long)i * G + c; if (L >= nwg) return false;
        int wgid = (int)L; { const int q = nwg / NXCD, r = nwg % NXCD, xcd = wgid % NXCD, off = wgid / NXCD; wgid = (xcd < r ? xcd * (q + 1) : r * (q + 1) + (xcd - r) * q) + off; }
        const int nig = WGM * nN, gid = wgid / nig, fm = gid * WGM, gsz = (nM - fm) < WGM ? (nM - fm) : WGM;
        u.pm = fm + ((wgid % nig) % gsz); u.pn = (wgid % nig) / gsz; return true;
    }
    __device__ __forceinline__ void a_ready(const Unit&) const {}
    __device__ __forceinline__ void done(const Unit&) const {}
};
struct PairOrder {
    StaticOrder so;
    __device__ bool next(int j, Unit& u) const { if (!so.next(j >> 1, u)) return false; u.pn += 4 * (j & 1); return true; }
    __device__ __forceinline__ void a_ready(const Unit&) const {}
    __device__ __forceinline__ void done(const Unit&) const {}
};


struct EpiProj {
    static constexpr bool PERM = true, AFTER_DRAIN = false, HAS_MID = false;
    unsigned char* ws; float* out; const float *bgate, *cw, *cb, *st;
    __device__ __forceinline__ void conv_tile(const f32x4 (&acc)[2][2][4][2], const Unit& u, int wr, int wc, int fr, int fq) const {
        const bool samp = u.pm == MP / BM; const int rowb = u.pm * BM + wr * 64 + fr;
        bf16_t* U = (bf16_t*)(ws + WS_UC); float* HALOU = (float*)(ws + WS_HALOU); float* FIXU = (float*)(ws + WS_FIXU);
#pragma unroll
        for (int bj = 0; bj < 2; ++bj)
#pragma unroll
        for (int n = 0; n < 2; ++n) {
            const int c = u.pn * BM + bj * HALF + wc * 32 + 8 * fq + 4 * n;
            const f32x4 w0 = *(const f32x4*)(cw + c), w1 = *(const f32x4*)(cw + DM + c), w2 = *(const f32x4*)(cw + 2 * DM + c), w3 = *(const f32x4*)(cw + 3 * DM + c), bias = *(const f32x4*)(cb + c);
#pragma unroll
            for (int ai = 0; ai < 2; ++ai) {
#pragma unroll
                for (int m = 0; m < 4; ++m) {
                    const int row = rowb + ai * HALF + m * 16; const f32x4 av = acc[ai][bj][m][n], pv = acc[ai][bj][m > 0 ? m - 1 : 0][n];
                    f32x4 p1, p2, p3; bool fix = false;
#pragma unroll
                    for (int e = 0; e < 4; ++e) { p1[e] = row_ror<1>(av[e]); p2[e] = row_ror<2>(av[e]); p3[e] = row_ror<3>(av[e]); }
                    if (samp) {
                        if (fr < 3) { const float* sp = st + (size_t)((row - MP) >> 4) * 3 * DM + c; const f32x4 s0 = *(const f32x4*)sp, s1 = *(const f32x4*)(sp + DM), s2 = *(const f32x4*)(sp + 2 * DM);
                            if (fr == 0) { p1 = s2; p2 = s1; p3 = s0; } else if (fr == 1) { p2 = s2; p3 = s1; } else p3 = s2; }
                    } else if (m > 0) {
#pragma unroll
                        for (int e = 0; e < 4; ++e) { const float q1 = row_ror<1>(pv[e]), q2 = row_ror<2>(pv[e]), q3 = row_ror<3>(pv[e]); if (fr < 1) p1[e] = q1; if (fr < 2) p2[e] = q2; if (fr < 3) p3[e] = q3; }
                    } else if (fr < 3) {
                        if ((row & (SEQ - 1)) < 3) { const f32x4 z = (f32x4){0.f, 0.f, 0.f, 0.f}; if (fr < 1) p1 = z; if (fr < 2) p2 = z; p3 = z; }
                        else fix = true;
                    }
                    if (fix) *(f32x4*)(FIXU + ((size_t)(row >> 6) * 3 + fr) * DM + c) = av;
                    else { const f32x4 y = p3 * w0 + p2 * w1 + p1 * w2 + av * w3 + bias; u32x2 w; w.x = cvt_pk_bf16(y[0], y[1]); w.y = cvt_pk_bf16(y[2], y[3]); *(u32x2*)(U + (size_t)row * DM + c) = w; }
                    if (!samp) {
                        if (m == 3 && fr >= 13) { *(f32x4*)(HALOU + ((size_t)(row >> 6) * 3 + (fr - 13)) * DM + c) = av;
                            if ((row & (SEQ - 1)) >= SEQ - 3) *(f32x4*)(out + O_RCP + ((size_t)(row >> 13) * 3 + (fr - 13)) * DM + c) = av; }
                    } else if (fr >= 13) *(f32x4*)(out + O_RCS + ((size_t)((row - MP) >> 4) * 3 + (fr - 13)) * DM + c) = av;
                }
            }
        }
    }
    __device__ __forceinline__ void operator()(const f32x4 (&acc)[2][2][4][2], const Unit& u, int wr, int wc, int fr, int fq) const {
        const int pn = u.pn; bf16_t* base; int ldc, colt; bool sig = false;
        if (pn < 4) { conv_tile(acc, u, wr, wc, fr, fq); return; }
        if (pn < 8) { base = (bf16_t*)(ws + WS_Q); ldc = 1024; colt = (pn - 4) * 256; }
        else if (pn < 10) { base = (bf16_t*)(ws + WS_KV); ldc = 512; colt = (pn - 8) * 256; } else { base = (bf16_t*)(ws + WS_GT); ldc = 2048; colt = (pn - 10) * 256; sig = true; }
        const int row0 = u.pm * BM + wr * 64 + fr, col0 = colt + wc * 32 + 8 * fq;
        f32x4 bv[2][2];
#pragma unroll
        for (int bj = 0; bj < 2; ++bj)
#pragma unroll
            for (int n = 0; n < 2; ++n) bv[bj][n] = sig ? *(const f32x4*)(bgate + col0 + bj * HALF + 4 * n) : (f32x4){0.f, 0.f, 0.f, 0.f};
#pragma unroll
        for (int ai = 0; ai < 2; ++ai)
#pragma unroll
            for (int m = 0; m < 4; ++m) { bf16_t* rowp = base + (size_t)(row0 + ai * HALF + m * 16) * ldc + col0;
#pragma unroll
                for (int bj = 0; bj < 2; ++bj) { f32x4 v0 = acc[ai][bj][m][0] + bv[bj][0], v1 = acc[ai][bj][m][1] + bv[bj][1];
                    if (sig) {
#pragma unroll
                        for (int e = 0; e < 4; ++e) { v0[e] = sigmoidf_(v0[e]); v1[e] = sigmoidf_(v1[e]); } }
                    u32x4 w; w.x = cvt_pk_bf16(v0[0], v0[1]); w.y = cvt_pk_bf16(v0[2], v0[3]); w.z = cvt_pk_bf16(v1[0], v1[1]); w.w = cvt_pk_bf16(v1[2], v1[3]);
                    *(u32x4*)(rowp + bj * HALF) = w; } }
    }
};
struct EpiUpF {
    static constexpr bool PERM = true, AFTER_DRAIN = false, HAS_MID = false;
    bf16_t* Gb; const float* rss2; const float* cw; const float* cb; const float* st; float* out; float* HALO; float* FIXA; float* FIXB;
    __device__ __forceinline__ void operator()(const f32x4 (&acc)[2][2][4][2], const Unit& u, int wr, int wc, int fr, int fq) const {
        const bool samp = u.pm == MP / BM;
        const int j0 = u.pn * HALF + wc * 32 + 8 * fq, rowb = u.pm * BM + wr * 64 + fr;
        float rs[2][4];
#pragma unroll
        for (int ai = 0; ai < 2; ++ai)
#pragma unroll
            for (int m = 0; m < 4; ++m) rs[ai][m] = rsqrtf(rss2[rowb + ai * HALF + m * 16] * (1.0f / DM) + EPS);
#pragma unroll
        for (int n = 0; n < 2; ++n) {
            const int j = j0 + 4 * n;
            const f32x4 w0 = *(const f32x4*)(cw + j), w1 = *(const f32x4*)(cw + DFF + j), w2 = *(const f32x4*)(cw + 2 * DFF + j), bias = *(const f32x4*)(cb + j);
#pragma unroll
            for (int ai = 0; ai < 2; ++ai) {
                f32x4 av[4], r1[4], r2[4];
#pragma unroll
                for (int m = 0; m < 4; ++m) { av[m] = acc[ai][0][m][n] * rs[ai][m];
#pragma unroll
                    for (int e = 0; e < 4; ++e) { r1[m][e] = row_ror<1>(av[m][e]); r2[m][e] = row_ror<2>(av[m][e]); } }
#pragma unroll
                for (int m = 0; m < 4; ++m) {
                    const int row = rowb + ai * HALF + m * 16;
                    const f32x4 bvv = acc[ai][1][m][n] * rs[ai][m];
                    f32x4 p1 = r1[m], p2 = r2[m]; bool fix = false;
                    if (samp) {
                        if (fr < 2) { const float* sp = st + (size_t)((row - MP) >> 4) * 2 * DFF + j; const f32x4 s0 = *(const f32x4*)sp, s1 = *(const f32x4*)(sp + DFF);
                            if (fr == 0) { p1 = s1; p2 = s0; } else p2 = s1; }
                    } else if (m > 0) { if (fr < 1) p1 = r1[m - 1]; if (fr < 2) p2 = r2[m - 1]; }
                    else if (fr < 2) {
                        if ((row & (SEQ - 1)) < 2) { const f32x4 z = (f32x4){0.f, 0.f, 0.f, 0.f}; if (fr == 0) p1 = z; p2 = z; }
                        else fix = true;
                    }
                    if (fix) { const size_t o = ((size_t)(row >> 6) * 2 + fr) * DFF + j; *(f32x4*)(FIXA + o) = av[m]; *(f32x4*)(FIXB + o) = bvv; }
                    else {
                        const f32x4 y = p2 * w0 + p1 * w1 + av[m] * w2 + bias; f32x4 g;
#pragma unroll
                        for (int e = 0; e < 4; ++e) g[e] = gelu_f(y[e]) * bvv[e];
                        u32x2 w; w.x = cvt_pk_bf16(g[0], g[1]); w.y = cvt_pk_bf16(g[2], g[3]); *(u32x2*)(Gb + (size_t)row * DFF + j) = w;
                    }
                    if (!samp) {
                        if (m == 3 && fr >= 14) { *(f32x4*)(HALO + ((size_t)(row >> 6) * 2 + (fr - 14)) * DFF + j) = av[m];
                            if ((row & (SEQ - 1)) >= SEQ - 2) *(f32x4*)(out + O_FCP + ((size_t)(row >> 13) * 2 + (fr - 14)) * DFF + j) = av[m]; }
                    } else if (fr >= 14) *(f32x4*)(out + O_FCS + ((size_t)((row - MP) >> 4) * 2 + (fr - 14)) * DFF + j) = av[m];
                }
            }
        }
    }
};
struct EpiMix {
    static constexpr bool PERM = true, AFTER_DRAIN = false, HAS_MID = false;
    bf16_t* MIX; const bf16_t* GT;
    __device__ __forceinline__ void operator()(const f32x4 (&acc)[2][2][4][2], const Unit& u, int wr, int wc, int fr, int fq) const {
        const int seg = u.pn >> 2, row0 = u.pm * BM + wr * 64 + fr, col0 = (u.pn & 3) * BM + wc * 32 + 8 * fq;
#pragma unroll
        for (int ai = 0; ai < 2; ++ai)
#pragma unroll
            for (int m = 0; m < 4; ++m) { const int row = row0 + ai * HALF + m * 16; bf16_t* rowp = MIX + (size_t)row * 1024 + col0; const bf16_t* gp = GT + (size_t)row * 2048 + seg * 1024 + col0;
#pragma unroll
                for (int bj = 0; bj < 2; ++bj) { const u32x4 g = *(const u32x4*)(gp + bj * HALF);
                    f32x4 v0 = acc[ai][bj][m][0], v1 = acc[ai][bj][m][1];
                    v0[0] *= bf_lo(g.x); v0[1] *= bf_hi(g.x); v0[2] *= bf_lo(g.y); v0[3] *= bf_hi(g.y); v1[0] *= bf_lo(g.z); v1[1] *= bf_hi(g.z); v1[2] *= bf_lo(g.w); v1[3] *= bf_hi(g.w);
                    if (seg) { const u32x4 p = *(const u32x4*)(rowp + bj * HALF);
                        v0[0] += bf_lo(p.x); v0[1] += bf_hi(p.x); v0[2] += bf_lo(p.y); v0[3] += bf_hi(p.y); v1[0] += bf_lo(p.z); v1[1] += bf_hi(p.z); v1[2] += bf_lo(p.w); v1[3] += bf_hi(p.w); }
                    u32x4 w; w.x = cvt_pk_bf16(v0[0], v0[1]); w.y = cvt_pk_bf16(v0[2], v0[3]); w.z = cvt_pk_bf16(v1[0], v1[1]); w.w = cvt_pk_bf16(v1[2], v1[3]);
                    *(u32x4*)(rowp + bj * HALF) = w; } }
    }
};
struct EpiMix2 {
    static constexpr bool PERM = true, AFTER_DRAIN = false, HAS_MID = true;
    bf16_t* MIX; const bf16_t* GT;
    __device__ __forceinline__ void mid(f32x4 (&acc)[2][2][4][2], const Unit& u, int wr, int wc, int fr, int fq) const {
        const int row0 = u.pm * BM + wr * 64 + fr, col0 = u.pn * BM + wc * 32 + 8 * fq;
#pragma unroll
        for (int ai = 0; ai < 2; ++ai)
#pragma unroll
            for (int m = 0; m < 4; ++m) { const bf16_t* gp = GT + (size_t)(row0 + ai * HALF + m * 16) * 2048 + col0;
#pragma unroll
                for (int bj = 0; bj < 2; ++bj) { const u32x4 gr = *(const u32x4*)(gp + bj * HALF), ga = *(const u32x4*)(gp + 1024 + bj * HALF);
                    const float r[8] = {bf_lo(gr.x), bf_hi(gr.x), bf_lo(gr.y), bf_hi(gr.y), bf_lo(gr.z), bf_hi(gr.z), bf_lo(gr.w), bf_hi(gr.w)};
                    const float q[8] = {bf_lo(ga.x), bf_hi(ga.x), bf_lo(ga.y), bf_hi(ga.y), bf_lo(ga.z), bf_hi(ga.z), bf_lo(ga.w), bf_hi(ga.w)};
#pragma unroll
                    for (int e = 0; e < 4; ++e) { acc[ai][bj][m][0][e] *= r[e] * __builtin_amdgcn_rcpf(fmaxf(q[e], 1e-30f)); acc[ai][bj][m][1][e] *= r[4 + e] * __builtin_amdgcn_rcpf(fmaxf(q[4 + e], 1e-30f)); } }
                if (m & 1) asm volatile("" ::: "memory"); }
    }
    __device__ __forceinline__ void operator()(const f32x4 (&acc)[2][2][4][2], const Unit& u, int wr, int wc, int fr, int fq) const {
        const int row0 = u.pm * BM + wr * 64 + fr, col0 = u.pn * BM + wc * 32 + 8 * fq;
#pragma unroll
        for (int ai = 0; ai < 2; ++ai)
#pragma unroll
            for (int m = 0; m < 4; ++m) { const int row = row0 + ai * HALF + m * 16; const bf16_t* gp = GT + (size_t)row * 2048 + 1024 + col0;
#pragma unroll
                for (int bj = 0; bj < 2; ++bj) { const u32x4 ga = *(const u32x4*)(gp + bj * HALF);
                    const float q[8] = {bf_lo(ga.x), bf_hi(ga.x), bf_lo(ga.y), bf_hi(ga.y), bf_lo(ga.z), bf_hi(ga.z), bf_lo(ga.w), bf_hi(ga.w)}; float v[8];
#pragma unroll
                    for (int e = 0; e < 4; ++e) { v[e] = acc[ai][bj][m][0][e] * fmaxf(q[e], 1e-30f); v[4 + e] = acc[ai][bj][m][1][e] * fmaxf(q[4 + e], 1e-30f); }
                    u32x4 w; w.x = cvt_pk_bf16(v[0], v[1]); w.y = cvt_pk_bf16(v[2], v[3]); w.z = cvt_pk_bf16(v[4], v[5]); w.w = cvt_pk_bf16(v[6], v[7]);
                    *(u32x4*)(MIX + (size_t)row * DM + col0 + bj * HALF) = w; } }
    }
};
struct EpiOut {
    static constexpr bool PERM = true, AFTER_DRAIN = false, HAS_MID = false;
    const float* xp; const float* xs; float* OUTY; bf16_t* X1B; float* rss2;
    __device__ __forceinline__ void operator()(const f32x4 (&acc)[2][2][4][2], const Unit& u, int wr, int wc, int fr, int fq) const {
        const int col0 = u.pn * BM + wc * 32 + 8 * fq;
#pragma unroll
        for (int ai = 0; ai < 2; ++ai)
#pragma unroll
            for (int m = 0; m < 4; ++m) { const int row = u.pm * BM + ai * HALF + wr * 64 + m * 16 + fr;
                const float* xrow = (row < MP) ? xp + (size_t)row * DM : xs + (size_t)(row - MP) * DM; float ss = 0.f;
#pragma unroll
                for (int bj = 0; bj < 2; ++bj) { const int c = col0 + bj * HALF;
                    const f32x4 o0 = *(const f32x4*)(xrow + c) + acc[ai][bj][m][0], o1 = *(const f32x4*)(xrow + c + 4) + acc[ai][bj][m][1];
                    ss += ((o0[0] * o0[0] + o0[1] * o0[1]) + (o0[2] * o0[2] + o0[3] * o0[3])) + ((o1[0] * o1[0] + o1[1] * o1[1]) + (o1[2] * o1[2] + o1[3] * o1[3]));
                    u32x4 w; w.x = cvt_pk_bf16(o0[0], o0[1]); w.y = cvt_pk_bf16(o0[2], o0[3]); w.z = cvt_pk_bf16(o1[0], o1[1]); w.w = cvt_pk_bf16(o1[2], o1[3]); *(u32x4*)(X1B + (size_t)row * DM + c) = w; }
                ss += __shfl_xor(ss, 16); ss += __shfl_xor(ss, 32);
                if (fq == 0) atomicAdd(rss2 + row, ss);
                if (m & 1) asm volatile("" ::: "memory"); }
    }
};
struct EpiDown {
    static constexpr bool PERM = true, AFTER_DRAIN = false, HAS_MID = false;
    float* OUTY; const bf16_t* X1B;
    __device__ __forceinline__ void operator()(const f32x4 (&acc)[2][2][4][2], const Unit& u, int wr, int wc, int fr, int fq) const {
        const int col0 = u.pn * BM + wc * 32 + 8 * fq;
#pragma unroll
        for (int ai = 0; ai < 2; ++ai)
#pragma unroll
            for (int m = 0; m < 4; ++m) { float* orow = OUTY + (size_t)(u.pm * BM + ai * HALF + wr * 64 + m * 16 + fr) * DM + col0;
#pragma unroll
                for (int bj = 0; bj < 2; ++bj) { float* p = orow + bj * HALF; const u32x4 xw = *(const u32x4*)(X1B + (p - OUTY));
                    *(f32x4*)p = (f32x4){bf_lo(xw.x), bf_hi(xw.x), bf_lo(xw.y), bf_hi(xw.y)} + acc[ai][bj][m][0]; *(f32x4*)(p + 4) = (f32x4){bf_lo(xw.z), bf_hi(xw.z), bf_lo(xw.w), bf_hi(xw.w)} + acc[ai][bj][m][1]; }
                if (m & 1) asm volatile("" ::: "memory"); }
    }
};
struct EpiGates {
    static constexpr bool PERM = true, AFTER_DRAIN = false, HAS_MID = false;
    const bf16_t* UC; bf16_t* LA; bf16_t* BV; const float *ba, *bx, *lam;
    __device__ __forceinline__ void operator()(const f32x4 (&acc)[2][2][4][2], const Unit& u, int wr, int wc, int fr, int fq) const {
        const int ch0 = u.pn * RB + wc * 32 + 8 * fq; const unsigned ro0 = (unsigned)(u.pm * BM + wr * 64 + fr) * DM + ch0;
        f32x4 vba[2], vbx[2], vsp[2];
#pragma unroll
        for (int n = 0; n < 2; ++n) { vba[n] = *(const f32x4*)(ba + ch0 + 4 * n); vbx[n] = *(const f32x4*)(bx + ch0 + 4 * n); const f32x4 l = *(const f32x4*)(lam + ch0 + 4 * n);
#pragma unroll
            for (int e = 0; e < 4; ++e) { const float z = -l[e]; vsp[n][e] = -8.0f * ((z > 20.f) ? z : log1pf(__expf(z))); } }
#pragma unroll
        for (int ai = 0; ai < 2; ++ai)
#pragma unroll
            for (int m = 0; m < 4; ++m) { unsigned ro = ro0 + (unsigned)((ai * HALF + m * 16) * DM); asm volatile("" : "+v"(ro));
                const u32x4 ucw = *(const u32x4*)(UC + ro); const float uc[8] = {bf_lo(ucw.x), bf_hi(ucw.x), bf_lo(ucw.y), bf_hi(ucw.y), bf_lo(ucw.z), bf_hi(ucw.z), bf_lo(ucw.w), bf_hi(ucw.w)};
                float la[8], bv[8];
#pragma unroll
                for (int n = 0; n < 2; ++n)
#pragma unroll
                    for (int e = 0; e < 4; ++e) { const float r = sigmoidf_(acc[ai][0][m][n][e] + vba[n][e]), ig = sigmoidf_(acc[ai][1][m][n][e] + vbx[n][e]);
                        const float l_ = r * vsp[n][e], em = 2.0f * l_;
                        const float om = (em > -0.02f) ? -em * (1.0f + em * (0.5f + em * 0.16666667f)) : 1.0f - __expf(em);
                        la[4 * n + e] = l_; bv[4 * n + e] = __builtin_amdgcn_sqrtf(om) * (ig * uc[4 * n + e]); }
                u32x4 w; w.x = cvt_pk_bf16(la[0], la[1]); w.y = cvt_pk_bf16(la[2], la[3]); w.z = cvt_pk_bf16(la[4], la[5]); w.w = cvt_pk_bf16(la[6], la[7]); *(u32x4*)(LA + ro) = w;
                w.x = cvt_pk_bf16(bv[0], bv[1]); w.y = cvt_pk_bf16(bv[2], bv[3]); w.z = cvt_pk_bf16(bv[4], bv[5]); w.w = cvt_pk_bf16(bv[6], bv[7]); *(u32x4*)(BV + ro) = w;
                if (m & 1) asm volatile("" ::: "memory"); }
    }
};

template <class Epi, class Sched, bool ALIGN_EPI = false, bool SP2 = false>
__device__ __forceinline__ void gemm_phase(PG8_LAS unsigned char* lds, const Gemm g, const Sched& S, const Epi& E) {
    const int tid = threadIdx.x, wid = __builtin_amdgcn_readfirstlane(tid >> 6), lane = tid & 63, wr = wid >> 2, wc = wid & 3, fr = lane & 15, fq = lane >> 4;
    int K = g.K; asm volatile("" : "+s"(K)); const int nt = K / BK;
    unsigned voffA[2], voffB[2];
#pragma unroll
    for (int i = 0; i < 2; ++i) { int R, C; stage_rc(tid * 16 + i * 8192, R, C); const int Rb = Epi::PERM ? ((R & ~31) + perm32(R & 31)) : R;
        voffA[i] = (unsigned)(R * g.lda + C) * 2u; voffB[i] = (unsigned)(Rb * g.ldb + C) * 2u; }
    const size_t kstep = (size_t)(BK * 2);
    const size_t hstepA = (size_t)HALF * g.lda * 2, hstepB = (size_t)HALF * g.ldb * 2;
    const unsigned ldsw = (unsigned)wid * 1024u;
    const int aoff = lds_byte(wr * 64 + fr, fq * 8), boff = lds_byte(wc * 32 + fr, fq * 8);
#define PG8_SA(b, h) (((b) * 2 + (h)) * HTB)
#define PG8_SB(b, h) ((4 + (b) * 2 + (h)) * HTB)
#define PG8_STAGE(bufoff, gbase, voff) do { _Pragma("unroll") for (int _i = 0; _i < 2; ++_i) \
        __builtin_amdgcn_global_load_lds((const unsigned*)((const char*)(gbase) + (voff)[_i]), (PG8_LAS unsigned*)(lds + (bufoff) + ldsw + _i * 8192), 16, 0, 0); } while (0)
#define PG8_LDA(dst, b, h) do { _Pragma("unroll") for (int m = 0; m < 4; ++m) _Pragma("unroll") for (int k = 0; k < 2; ++k) dst[m][k] = *(const PG8_LAS bf16x8*)(lds + PG8_SA(b, h) + aoff + m * 2048 + k * 1024); } while (0)
#define PG8_LDB(dst, b, h) do { _Pragma("unroll") for (int n = 0; n < 2; ++n) _Pragma("unroll") for (int k = 0; k < 2; ++k) dst[n][k] = *(const PG8_LAS bf16x8*)(lds + PG8_SB(b, h) + boff + n * 2048 + k * 1024); } while (0)
#define PG8_MMA(ai, bj, At, Bt) do { __builtin_amdgcn_s_setprio(1); _Pragma("unroll") for (int m = 0; m < 4; ++m) _Pragma("unroll") for (int n = 0; n < 2; ++n) _Pragma("unroll") for (int k = 0; k < 2; ++k) \
        acc[ai][bj][m][n] = __builtin_amdgcn_mfma_f32_16x16x32_bf16(Bt[n][k], At[m][k], acc[ai][bj][m][n], 0, 0, 0); __builtin_amdgcn_s_setprio(0); } while (0)
#define PG8_WAIT_V(n) asm volatile("s_waitcnt vmcnt(" #n ")" ::: "memory")
#define PG8_WAIT_L(n) asm volatile("s_waitcnt lgkmcnt(" #n ")" ::: "memory")
#define PG8_BAR __builtin_amdgcn_s_barrier()
#define PG8_SCHED __builtin_amdgcn_sched_barrier(0)
    Unit cur, nxt; int ui = 0;
    if (!S.next(0, cur)) return;
    f32x4 acc[2][2][4][2];
#pragma unroll
    for (int a = 0; a < 2; ++a)
#pragma unroll
        for (int b = 0; b < 2; ++b)
#pragma unroll
            for (int m = 0; m < 4; ++m)
#pragma unroll
                for (int n = 0; n < 2; ++n) acc[a][b][m][n] = (f32x4){0.f, 0.f, 0.f, 0.f};
    bf16x8 At[4][2], B0[2][2], B1[2][2];
    const char* cA = g.a_ptr(cur); const char* cB = g.b_ptr(cur); const char* cA3 = g.ksplit ? g.a3_ptr(cur) : cA;
    S.a_ready(cur);
    if constexpr (SP2) {
        PG8_STAGE(PG8_SB(0, 0), cB, voffB); PG8_STAGE(PG8_SB(0, 1), cB + hstepB, voffB); PG8_STAGE(PG8_SA(0, 0), cA, voffA); PG8_STAGE(PG8_SA(0, 1), cA + hstepA, voffA);
        if (wr == 1) PG8_BAR;
        PG8_WAIT_V(2); PG8_BAR;
        PG8_STAGE(PG8_SB(1, 0), cB + kstep, voffB); PG8_STAGE(PG8_SA(1, 0), cA + kstep, voffA); PG8_STAGE(PG8_SB(1, 1), cB + hstepB + kstep, voffB);
        PG8_WAIT_V(6); PG8_BAR;
    } else {
        PG8_STAGE(PG8_SB(0, 0), cB, voffB); PG8_STAGE(PG8_SA(0, 0), cA, voffA); PG8_STAGE(PG8_SB(0, 1), cB + hstepB, voffB); PG8_STAGE(PG8_SA(0, 1), cA + hstepA, voffA);
        if (wr == 1) PG8_BAR;
        PG8_WAIT_V(4); PG8_BAR;
        PG8_STAGE(PG8_SB(1, 0), cB + kstep, voffB); PG8_STAGE(PG8_SA(1, 0), cA + kstep, voffA); PG8_STAGE(PG8_SB(1, 1), cB + hstepB + kstep, voffB);
        PG8_WAIT_V(6); PG8_BAR;
    }
    for (;;) {
        const bool has_next = S.next(ui + 1, nxt);
        const char* nA = has_next ? g.a_ptr(nxt) : cA; const char* nB = has_next ? g.b_ptr(nxt) : cB;
        for (int t = 0; t < nt; t += 2) {
            const bool last = (t == nt - 2);
            if constexpr (Epi::HAS_MID) { if (t == g.ksplit) E.mid(acc, cur, wr, wc, fr, fq); }
            const char* a1 = ((g.ksplit && t + 1 >= g.ksplit) ? cA3 : cA) + (size_t)(t + 1) * kstep;
            const char* a2 = last ? nA : ((g.ksplit && t + 2 >= g.ksplit) ? cA3 : cA) + (size_t)(t + 2) * kstep; const char* b2 = last ? nB : cB + (size_t)(t + 2) * kstep;
            const char* a3 = a2 + kstep; const char* b3 = b2 + kstep;
            if (last && has_next) S.a_ready(nxt);
            if constexpr (SP2) {
            PG8_LDB(B0, 0, 0); PG8_LDB(B1, 0, 1); PG8_SCHED; PG8_LDA(At, 0, 0); PG8_STAGE(PG8_SA(1, 1), a1 + hstepA, voffA);
            PG8_WAIT_V(8); PG8_WAIT_L(0); PG8_BAR; PG8_MMA(0, 0, At, B0); PG8_MMA(0, 1, At, B1); PG8_BAR; PG8_SCHED;
            PG8_LDA(At, 0, 1); PG8_STAGE(PG8_SB(0, 0), b2, voffB); PG8_STAGE(PG8_SB(0, 1), b2 + hstepB, voffB); PG8_STAGE(PG8_SA(0, 0), a2, voffA);
            PG8_WAIT_V(8); PG8_WAIT_L(0); PG8_BAR; PG8_MMA(1, 0, At, B0); PG8_MMA(1, 1, At, B1); PG8_BAR; PG8_SCHED;
            PG8_LDB(B0, 1, 0); PG8_LDB(B1, 1, 1); PG8_SCHED; PG8_LDA(At, 1, 0); PG8_STAGE(PG8_SA(0, 1), a2 + hstepA, voffA);
            PG8_WAIT_V(8); PG8_WAIT_L(0); PG8_BAR; PG8_MMA(0, 0, At, B0); PG8_MMA(0, 1, At, B1); PG8_BAR; PG8_SCHED;
            PG8_LDA(At, 1, 1); PG8_STAGE(PG8_SB(1, 0), b3, voffB); PG8_STAGE(PG8_SB(1, 1), b3 + hstepB, voffB); PG8_STAGE(PG8_SA(1, 0), a3, voffA);
            PG8_WAIT_V(8); PG8_WAIT_L(0); PG8_BAR; PG8_MMA(1, 0, At, B0); PG8_MMA(1, 1, At, B1); PG8_BAR; PG8_SCHED;
            } else {
            PG8_LDB(B0, 0, 0); PG8_SCHED; PG8_LDA(At, 0, 0); PG8_STAGE(PG8_SA(1, 1), a1 + hstepA, voffA);
            PG8_WAIT_L(8); PG8_BAR; PG8_WAIT_L(0); PG8_MMA(0, 0, At, B0); PG8_BAR; PG8_SCHED;
            PG8_LDB(B1, 0, 1); PG8_STAGE(PG8_SB(0, 0), b2, voffB);
            PG8_BAR; PG8_WAIT_L(0); PG8_MMA(0, 1, At, B1); PG8_BAR;
            PG8_LDA(At, 0, 1); PG8_STAGE(PG8_SA(0, 0), a2, voffA);
            PG8_BAR; PG8_WAIT_L(0); PG8_MMA(1, 0, At, B0); PG8_BAR; PG8_SCHED;
            PG8_STAGE(PG8_SB(0, 1), b2 + hstepB, voffB);
            PG8_WAIT_V(6); PG8_BAR; PG8_MMA(1, 1, At, B1); PG8_BAR;
            PG8_LDB(B0, 1, 0); PG8_SCHED; PG8_LDA(At, 1, 0); PG8_STAGE(PG8_SA(0, 1), a2 + hstepA, voffA);
            PG8_WAIT_L(8); PG8_BAR; PG8_WAIT_L(0); PG8_MMA(0, 0, At, B0); PG8_BAR; PG8_SCHED;
            PG8_LDB(B1, 1, 1); PG8_STAGE(PG8_SB(1, 0), b3, voffB);
            PG8_BAR; PG8_WAIT_L(0); PG8_MMA(0, 1, At, B1); PG8_BAR;
            PG8_LDA(At, 1, 1); PG8_STAGE(PG8_SA(1, 0), a3, voffA);
            PG8_BAR; PG8_WAIT_L(0); PG8_MMA(1, 0, At, B0); PG8_BAR; PG8_SCHED;
            PG8_STAGE(PG8_SB(1, 1), b3 + hstepB, voffB);
            PG8_WAIT_V(6); PG8_BAR; PG8_MMA(1, 1, At, B1); PG8_BAR;
            }
        }
        if constexpr (ALIGN_EPI) { if (wr == 0) PG8_BAR; }
        if constexpr (!Epi::AFTER_DRAIN) { E(acc, cur, wr, wc, fr, fq); S.done(cur); }
        if (!has_next) break;
#pragma unroll
        for (int a = 0; a < 2; ++a)
#pragma unroll
            for (int b = 0; b < 2; ++b)
#pragma unroll
                for (int m = 0; m < 4; ++m)
#pragma unroll
                    for (int n = 0; n < 2; ++n) acc[a][b][m][n] = (f32x4){0.f, 0.f, 0.f, 0.f};
        cur = nxt; cA = nA; cB = nB; cA3 = g.ksplit ? g.a3_ptr(cur) : cA; ++ui;
        if constexpr (ALIGN_EPI) { if (wr == 1) PG8_BAR; }
    }
    PG8_WAIT_V(0);
    if constexpr (!ALIGN_EPI) { if (wr == 0) PG8_BAR; }
    PG8_BAR;
    if constexpr (Epi::AFTER_DRAIN) { E.fused(acc, cur, wr, wc, fr, fq, lds, wid, lane); S.done(cur); }
#undef PG8_SA
#undef PG8_SB
#undef PG8_STAGE
#undef PG8_LDA
#undef PG8_LDB
#undef PG8_MMA
#undef PG8_WAIT_V
#undef PG8_WAIT_L
#undef PG8_BAR
#undef PG8_SCHED
}
}

#define XB_TMO      128
#define XB_XCNT(j)  (256  + 64 * (j))
#define XB_XSUB(j)  (1280 + 64 * (j))
#define XB_XGEN(j)  (2304 + 64 * (j))
#define XB_TOP      3328
#define XB_TOPGEN   3392
#define XCD_BAR_WORDS 3456
#define XB_SPIN_CAP (1u << 18)

__device__ __forceinline__ unsigned xb_ld(unsigned* p)              { return __hip_atomic_load(p, __ATOMIC_RELAXED, __HIP_MEMORY_SCOPE_AGENT); }
__device__ __forceinline__ unsigned xb_add(unsigned* p, unsigned v) { return __hip_atomic_fetch_add(p, v, __ATOMIC_RELAXED, __HIP_MEMORY_SCOPE_AGENT); }
__device__ __forceinline__ unsigned xb_xcc_id() { return (unsigned)__builtin_amdgcn_s_getreg((3 << 11) | 20) & 0xFu; }
#define XB_SPIN(cond, bar) do { unsigned _sp = 0; while (cond) { __builtin_amdgcn_s_sleep(1); \
    if ((++_sp & 255u) == 0u) { if (xb_ld(&(bar)[XB_TMO])) break; if (_sp > XB_SPIN_CAP) { atomicAdd(&(bar)[XB_TMO], 1u); break; } } } } while (0)

struct XcdBarrier {
    unsigned* bar; unsigned x;
    volatile LAS unsigned* st;
};

__device__ __forceinline__ XcdBarrier xcd_barrier_post(unsigned* bar, volatile LAS unsigned* st) {
    XcdBarrier b; b.bar = bar; b.x = xb_xcc_id(); b.st = st;
    if (threadIdx.x == 0) (void)xb_add(&bar[XB_XCNT(b.x)], 1u);
    return b;
}
__device__ __forceinline__ void xcd_barrier_complete(unsigned* bar, unsigned x, unsigned& nloc, unsigned& nx) {
    const unsigned G = gridDim.x * gridDim.y * gridDim.z;
    unsigned sum, cnt, mine, sp = 0u;
    for (;;) {
        sum = 0u; cnt = 0u; mine = 0u;
#pragma unroll
        for (unsigned j = 0; j < 16; ++j) { const unsigned c = xb_ld(&bar[XB_XCNT(j)]); sum += c; cnt += (c > 0u) ? 1u : 0u; mine = (j == x) ? c : mine; }
        if (sum == G) break;
        __builtin_amdgcn_s_sleep(1);
        if ((++sp & 255u) == 0u) { if (xb_ld(&bar[XB_TMO])) break; if (sp > XB_SPIN_CAP) { atomicAdd(&bar[XB_TMO], 1u); break; } }
    }
    nloc = mine > 0u ? mine : 1u; nx = cnt > 0u ? cnt : 1u;
}

__device__ __forceinline__ void xcd_barrier(const XcdBarrier& b) {
    asm volatile("s_waitcnt vmcnt(0)" ::: "memory");
    __syncthreads();
    if (threadIdx.x == 0) {
        unsigned* bar = b.bar;
        __builtin_amdgcn_s_waitcnt(0);
        unsigned nloc = b.st[0], nx = b.st[1];
        if (nloc == 0u) { xcd_barrier_complete(bar, b.x, nloc, nx); b.st[0] = nloc; b.st[1] = nx; }
        const unsigned old = xb_add(&bar[XB_XSUB(b.x)], 1u);
        const unsigned gen = old / nloc;
        if (old + 1u == (gen + 1u) * nloc) {
            __builtin_amdgcn_fence(__ATOMIC_RELEASE, "agent");
            asm volatile("s_waitcnt vmcnt(0)" ::: "memory");
            const unsigned og = xb_add(&bar[XB_TOP], 1u);
            const unsigned tg = og / nx;
            if (og + 1u == (tg + 1u) * nx) xb_add(&bar[XB_TOPGEN], 1u);
            else XB_SPIN(xb_ld(&bar[XB_TOPGEN]) == tg, bar);
            __builtin_amdgcn_fence(__ATOMIC_ACQUIRE, "agent");
            xb_add(&bar[XB_XGEN(b.x)], 1u);
            asm volatile("s_waitcnt vmcnt(0)" ::: "memory");
        } else {
            XB_SPIN(xb_ld(&bar[XB_XGEN(b.x)]) == gen, bar);
            __builtin_amdgcn_fence(__ATOMIC_ACQUIRE, "agent");
            asm volatile("s_waitcnt vmcnt(0)" ::: "memory");
        }
    }
    __syncthreads();
}

constexpr int NWAVES = 8, NTHR = NWAVES * 64;
constexpr int LDS_BYTES = 147456;
#define LDS_WAIT() asm volatile("s_waitcnt lgkmcnt(0)" ::: "memory")

struct Args {
    const float* in[28]; float* out; unsigned char* ws; int ph_lo, ph_hi;
};
enum { I_XP = 0, I_XS, I_SRC, I_SRH, I_CK, I_CV, I_SFC, I_NMG, I_WIN, I_BG, I_RCW, I_RCB, I_GAW, I_GAB, I_GXW, I_GXB, I_LAM, I_QG, I_KG, I_SINK, I_WRP, I_WAP, I_WOUT, I_NFG, I_WUP, I_FCW, I_FCB, I_WDN };

__device__ __forceinline__ float wave_sum(float v) {
#pragma unroll
    for (int o = 1; o < 64; o <<= 1) v += __shfl_xor(v, o);
    return v;
}
template <bool UPMAP = false> __device__ __forceinline__ void p0_transpose_item(const float* W, int K, int N, bf16_t* WT, int row_off, const float* ks, LAS float* scr, int item, int lane, int ldw = 0, int koff = 0) {
    const int nblk = N / 32, kb = item / nblk, nb = item % nblk, k0 = 64 * kb, n0 = 32 * nb;
#pragma unroll 8
    for (int i = 0; i < 32; ++i) { const int kk = 2 * i + (lane >> 5); float v = W[(size_t)(k0 + kk) * N + n0 + (lane & 31)]; if (ks) v *= ks[k0 + kk]; scr[kk * 33 + (lane & 31)] = v; }
    LDS_WAIT(); asm volatile("" ::: "memory");
    const int c = lane & 7;
#pragma unroll
    for (int j = 0; j < 4; ++j) { const int n = (lane >> 3) + 8 * j; const LAS float* s = scr + (8 * c) * 33 + n;
        u32x4 o; o.x = cvt_pk_bf16(s[0 * 33], s[1 * 33]); o.y = cvt_pk_bf16(s[2 * 33], s[3 * 33]); o.z = cvt_pk_bf16(s[4 * 33], s[5 * 33]); o.w = cvt_pk_bf16(s[6 * 33], s[7 * 33]);
        int orow = row_off + n0 + n;
        if (UPMAP) { const int nn = n0 + n, hf = nn >= DFF ? 1 : 0, jj = nn - hf * DFF; orow = (jj >> 7) * 256 + hf * 128 + (jj & 127); }
        *(u32x4*)(WT + (size_t)orow * (ldw ? ldw : K) + koff + k0 + 8 * c) = o; }
    LDS_WAIT(); asm volatile("" ::: "memory");
}

__device__ __forceinline__ void p0_prologue(const Args& a, LAS unsigned char* lds, int G, bool late) {
    const int tid = threadIdx.x, lane = tid & 63, wave = tid >> 6;
    LAS float* scr = (LAS float*)(lds + wave * 16384);
    const int skip = (late && G > 32) ? 16 : 0;
    if ((int)blockIdx.x < skip) return;
    const int gw = ((int)blockIdx.x - skip) * NWAVES + wave, NGW = (G - skip) * NWAVES;
    unsigned char* ws = a.ws;
    constexpr int T_IN = 16 * (INW / 32), T_SQ = 16 * 32, T_UP = 16 * (UPW / 32), T_DN = (DFF / 64) * 32, T_G = 16 * 8;
    constexpr int NITEMS = T_IN + 3 * T_SQ + T_UP + T_DN + T_G;
    for (int it = (late ? T_IN + T_G : 0) + gw; it < (late ? NITEMS : T_IN + T_G); it += NGW) {
        int r = it;
        if (r < T_IN) { p0_transpose_item(a.in[I_WIN], DM, INW, (bf16_t*)(ws + WS_WIN), 0, nullptr, scr, r, lane); continue; } r -= T_IN;
        if (r < T_G) { const int mat = r >> 3, sub = r & 7, blk = mat >> 1, which = mat & 1;
          p0_transpose_item(a.in[which ? I_GXW : I_GAW] + (size_t)blk * RB * RB, RB, RB, (bf16_t*)(ws + WS_WG) + (size_t)blk * 256 * RB, which * RB, nullptr, scr, sub, lane); continue; } r -= T_G;
        if (r < T_SQ) { p0_transpose_item(a.in[I_WRP], DM, DM, (bf16_t*)(ws + WS_WMIX), 0, nullptr, scr, r, lane, 2048, 0); continue; } r -= T_SQ;
        if (r < T_SQ) { p0_transpose_item(a.in[I_WAP], DM, DM, (bf16_t*)(ws + WS_WMIX), 0, nullptr, scr, r, lane, 2048, 1024); continue; } r -= T_SQ;
        if (r < T_SQ) { p0_transpose_item(a.in[I_WOUT], DM, DM, (bf16_t*)(ws + WS_WOUT), 0, nullptr, scr, r, lane); continue; } r -= T_SQ;
        if (r < T_UP) { p0_transpose_item<true>(a.in[I_WUP], DM, UPW, (bf16_t*)(ws + WS_WUP), 0, a.in[I_NFG], scr, r, lane); continue; } r -= T_UP;
        p0_transpose_item(a.in[I_WDN], DFF, DM, (bf16_t*)(ws + WS_WDN), 0, nullptr, scr, r, lane);
    }
    if (late) return;
    const float* g = a.in[I_NMG];
    f32x4 gv[4];
#pragma unroll
    for (int j = 0; j < 4; ++j) gv[j] = *((const f32x4*)g + lane + 64 * j);
    bf16_t* XB = (bf16_t*)(ws + WS_XB);
    for (int m0 = gw; m0 < MTOT; m0 += 4 * NGW) {
        f32x4 v[4][4];
#pragma unroll
        for (int r = 0; r < 4; ++r) { const int m = m0 + r * NGW; if (m < MTOT) {
            const float* xrow = (m < MP) ? a.in[I_XP] + (size_t)m * DM : a.in[I_XS] + (size_t)(m - MP) * DM; const f32x4* xr = (const f32x4*)xrow + lane;
#pragma unroll
            for (int j = 0; j < 4; ++j) v[r][j] = xr[64 * j]; } }
#pragma unroll
        for (int r = 0; r < 4; ++r) { const int m = m0 + r * NGW; if (m < MTOT) {
            float s = 0.f;
#pragma unroll
            for (int j = 0; j < 4; ++j) s += (v[r][j].x * v[r][j].x + v[r][j].y * v[r][j].y) + (v[r][j].z * v[r][j].z + v[r][j].w * v[r][j].w);
            const float rs = rsqrtf(wave_sum(s) * (1.f / DM) + EPS);
            u32x2* o8 = (u32x2*)(XB + (size_t)m * DM) + lane;
#pragma unroll
            for (int j = 0; j < 4; ++j) { const f32x4 t = v[r][j] * rs * gv[j]; u32x2 w; w.x = cvt_pk_bf16(t.x, t.y); w.y = cvt_pk_bf16(t.z, t.w); o8[64 * j] = w; } } }
    }
    float* rss2 = (float*)(ws + WS_RSS2);
    for (int i = blockIdx.x * NTHR + tid; i < MTOT; i += G * NTHR) rss2[i] = 0.f;
}

__device__ __forceinline__ void conv_fix(const Args& a, int G) {
    bf16_t* UC = (bf16_t*)(a.ws + WS_UC);
    const float* HALOU = (const float*)(a.ws + WS_HALOU); const float* FIXU = (const float*)(a.ws + WS_FIXU);
    const float* cw = a.in[I_RCW]; const float* cb = a.in[I_RCB];
    constexpr int NG4 = DM / 4, NGRP = MP / 64;
    for (int it = blockIdx.x * NTHR + threadIdx.x; it < NGRP * NG4; it += G * NTHR) {
        const int g = it / NG4, c = (it - g * NG4) * 4;
        if ((g & (SEQ / 64 - 1)) == 0) continue;
        const f32x4 w0 = *(const f32x4*)(cw + c), w1 = *(const f32x4*)(cw + DM + c), w2 = *(const f32x4*)(cw + 2 * DM + c), w3 = *(const f32x4*)(cw + 3 * DM + c), bias = *(const f32x4*)(cb + c);
        f32x4 x[6];
#pragma unroll
        for (int k = 0; k < 3; ++k) { x[k] = *(const f32x4*)(HALOU + ((size_t)(g - 1) * 3 + k) * DM + c); x[3 + k] = *(const f32x4*)(FIXU + ((size_t)g * 3 + k) * DM + c); }
#pragma unroll
        for (int k = 0; k < 3; ++k) { const f32x4 y = x[k] * w0 + x[k + 1] * w1 + x[k + 2] * w2 + x[k + 3] * w3 + bias;
            u32x2 w; w.x = cvt_pk_bf16(y[0], y[1]); w.y = cvt_pk_bf16(y[2], y[3]); *(u32x2*)(UC + (size_t)(g * 64 + k) * DM + c) = w; }
    }
}

constexpr int KS_STRIDE = 272, VT_STRIDE = 392;
constexpr int KS_OFF = 0, VT_OFF = 192 * KS_STRIDE;
static_assert(VT_OFF + 128 * VT_STRIDE <= 131072, "attention LDS");

__device__ __forceinline__ void attn_phase(const Args& a, LAS unsigned char* lds, int G) {
    const int tid = threadIdx.x, lane = tid & 63, wave = __builtin_amdgcn_readfirstlane(tid >> 6), fr = lane & 15, fq = lane >> 4;
    const bf16_t* Q = (const bf16_t*)(a.ws + WS_Q); const bf16_t* KV = (const bf16_t*)(a.ws + WS_KV); bf16_t* YA = (bf16_t*)(a.ws + WS_YA);
    const float* qg = a.in[I_QG]; const float* kg = a.in[I_KG]; const float* sinks = a.in[I_SINK];
    constexpr int NPI = NBATCH * NCH * NKV;
    constexpr int NIT = NPI + SBATCH * NKV;
    const int vbid = (G % 8 == 0) ? (int)(blockIdx.x % 8) * (G / 8) + (int)(blockIdx.x / 8) : (int)blockIdx.x;
    for (int item = vbid; item < NIT; item += G) {
        const bool samp = item >= NPI;
        int b, c, kvh, kstart, nkeys, kpos0; long rowbase;
        if (!samp) { kvh = item & 1; c = (item >> 1) & (NCH - 1); b = item >> 8; kstart = (c >= 2) ? 0 : (2 - c) * 64; nkeys = 192; kpos0 = (c - 2) * 64; rowbase = (long)b * SEQ + (long)(c - 2) * 64; }
        else { const int si = item - NPI; kvh = si & 1; b = si >> 1; c = 0; kstart = 0; nkeys = 160; kpos0 = PAST - WIN; rowbase = (long)MP + b * SSEQ - 128; }
        const int hl = samp ? wave : (wave >> 1), th = samp ? 0 : (wave & 1), h = kvh * GRP + hl;
        const bool active = !samp || wave < 4;
        u32x4 qraw[2][4];
        const long qr0 = samp ? ((long)MP + b * SSEQ + fr) : ((long)b * SEQ + c * 64 + 32 * th + fr);
#pragma unroll
        for (int ks = 0; ks < 4; ++ks) qraw[0][ks] = active ? *(const u32x4*)(Q + (size_t)qr0 * DM + h * HD + 32 * ks + 8 * fq) : (u32x4){0u, 0u, 0u, 0u};
#pragma unroll
        for (int ks = 0; ks < 4; ++ks) qraw[1][ks] = (active && !samp) ? *(const u32x4*)(Q + (size_t)(qr0 + 16) * DM + h * HD + 32 * ks + 8 * fq) : (u32x4){0u, 0u, 0u, 0u};
        __syncthreads();
        if (!samp) {
            u32x4 kraw[6], vraw[6];
#pragma unroll
            for (int i = 0; i < 6; ++i) { const int ci = tid + i * NTHR, key = ci >> 4, d0 = (ci & 15) * 8;
                if (key >= kstart) { const bf16_t* rp = KV + (size_t)(rowbase + key) * 512 + kvh * HD + d0; kraw[i] = *(const u32x4*)rp; vraw[i] = *(const u32x4*)(rp + 256); }
                else { kraw[i] = (u32x4){0u, 0u, 0u, 0u}; vraw[i] = kraw[i]; } }
            const int d0 = (tid & 15) * 8;
            float kgv[8];
#pragma unroll
            for (int e = 0; e < 8; ++e) kgv[e] = kg[d0 + e];
#pragma unroll
            for (int i = 0; i < 6; ++i) {
                const int key = (tid >> 4) + i * 32; const bool valid = key >= kstart;
                const u32x4 kw = kraw[i], vw = vraw[i];
                float kv[8] = {bf_lo(kw.x), bf_hi(kw.x), bf_lo(kw.y), bf_hi(kw.y), bf_lo(kw.z), bf_hi(kw.z), bf_lo(kw.w), bf_hi(kw.w)};
                float ss = 0.f;
#pragma unroll
                for (int e = 0; e < 8; ++e) ss += kv[e] * kv[e];
                ss += __shfl_xor(ss, 1); ss += __shfl_xor(ss, 2); ss += __shfl_xor(ss, 4); ss += __shfl_xor(ss, 8);
                const float rs = valid ? rsqrtf(ss * (1.f / HD) + EPS) : 0.f;
#pragma unroll
                for (int e = 0; e < 8; ++e) kv[e] = kv[e] * rs * kgv[e];
                u32x4 w; w.x = cvt_pk_bf16(kv[0], kv[1]); w.y = cvt_pk_bf16(kv[2], kv[3]); w.z = cvt_pk_bf16(kv[4], kv[5]); w.w = cvt_pk_bf16(kv[6], kv[7]);
                *(LAS u32x4*)(lds + KS_OFF + key * KS_STRIDE + d0 * 2) = w;
                const unsigned vq[4] = {vw.x, vw.y, vw.z, vw.w};
#pragma unroll
                for (int e = 0; e < 8; ++e) *(LAS bf16_t*)(lds + VT_OFF + (d0 + e) * VT_STRIDE + (key ^ (((d0 >> 3) & 7) << 2)) * 2) = (bf16_t)((e & 1) ? (vq[e >> 1] >> 16) : (vq[e >> 1] & 0xffffu));
                if (c >= NCH - 2 && key >= 128) { const size_t o = (((size_t)b * WIN + (size_t)(c - (NCH - 2)) * 64 + (key - 128)) * NKV + kvh) * HD + d0;
                    *(f32x4*)(a.out + O_KP + o) = (f32x4){kv[0], kv[1], kv[2], kv[3]}; *(f32x4*)(a.out + O_KP + o + 4) = (f32x4){kv[4], kv[5], kv[6], kv[7]};
                    *(f32x4*)(a.out + O_VP + o) = (f32x4){bf_lo(vw.x), bf_hi(vw.x), bf_lo(vw.y), bf_hi(vw.y)}; *(f32x4*)(a.out + O_VP + o + 4) = (f32x4){bf_lo(vw.z), bf_hi(vw.z), bf_lo(vw.w), bf_hi(vw.w)}; }
                asm volatile("" ::: "memory");
            }
        } else {
#pragma unroll
        for (int ii = 0; ii < 5; ++ii) { const int ci = tid + ii * NTHR;
            const int key = ci >> 4, d0 = (ci & 15) * 8;
            float kv[8], vv[8]; bool valid = key < 144, donorm = true;
            if (valid) {
                if (key < 128) { donorm = false;
                    const float* kp = a.in[I_CK] + (((size_t)b * WIN + key) * NKV + kvh) * HD + d0; const float* vp = a.in[I_CV] + (((size_t)b * WIN + key) * NKV + kvh) * HD + d0;
                    const f32x4 k0 = *(const f32x4*)kp, k1 = *(const f32x4*)(kp + 4), v0 = *(const f32x4*)vp, v1 = *(const f32x4*)(vp + 4);
#pragma unroll
                    for (int e = 0; e < 4; ++e) { kv[e] = k0[e]; kv[4 + e] = k1[e]; vv[e] = v0[e]; vv[4 + e] = v1[e]; }
                } else {
                    const bf16_t* rp = KV + (size_t)(rowbase + key) * 512 + kvh * HD + d0;
                    const u32x4 kw = *(const u32x4*)rp, vw = *(const u32x4*)(rp + 256);
                    kv[0] = bf_lo(kw.x); kv[1] = bf_hi(kw.x); kv[2] = bf_lo(kw.y); kv[3] = bf_hi(kw.y); kv[4] = bf_lo(kw.z); kv[5] = bf_hi(kw.z); kv[6] = bf_lo(kw.w); kv[7] = bf_hi(kw.w);
                    vv[0] = bf_lo(vw.x); vv[1] = bf_hi(vw.x); vv[2] = bf_lo(vw.y); vv[3] = bf_hi(vw.y); vv[4] = bf_lo(vw.z); vv[5] = bf_hi(vw.z); vv[6] = bf_lo(vw.w); vv[7] = bf_hi(vw.w);
                }
            } else {
#pragma unroll
                for (int e = 0; e < 8; ++e) { kv[e] = 0.f; vv[e] = 0.f; }
            }
            float ss = 0.f;
#pragma unroll
            for (int e = 0; e < 8; ++e) ss += kv[e] * kv[e];
            ss += __shfl_xor(ss, 1); ss += __shfl_xor(ss, 2); ss += __shfl_xor(ss, 4); ss += __shfl_xor(ss, 8);
            if (valid && donorm) { const float rs = rsqrtf(ss * (1.f / HD) + EPS);
#pragma unroll
                for (int e = 0; e < 8; ++e) kv[e] = kv[e] * rs * kg[d0 + e]; }
            u32x4 w; w.x = cvt_pk_bf16(kv[0], kv[1]); w.y = cvt_pk_bf16(kv[2], kv[3]); w.z = cvt_pk_bf16(kv[4], kv[5]); w.w = cvt_pk_bf16(kv[6], kv[7]);
            *(LAS u32x4*)(lds + KS_OFF + key * KS_STRIDE + d0 * 2) = w;
            u32x4 vw2; vw2.x = cvt_pk_bf16(vv[0], vv[1]); vw2.y = cvt_pk_bf16(vv[2], vv[3]); vw2.z = cvt_pk_bf16(vv[4], vv[5]); vw2.w = cvt_pk_bf16(vv[6], vv[7]);
            const unsigned vq[4] = {vw2.x, vw2.y, vw2.z, vw2.w};
#pragma unroll
            for (int e = 0; e < 8; ++e) *(LAS bf16_t*)(lds + VT_OFF + (d0 + e) * VT_STRIDE + (key ^ (((d0 >> 3) & 7) << 2)) * 2) = (bf16_t)((e & 1) ? (vq[e >> 1] >> 16) : (vq[e >> 1] & 0xffffu));
            if (key >= 16 && key < 144) { const size_t o = (((size_t)b * WIN + (key - 16)) * NKV + kvh) * HD + d0;
                *(f32x4*)(a.out + O_KS + o) = (f32x4){kv[0], kv[1], kv[2], kv[3]}; *(f32x4*)(a.out + O_KS + o + 4) = (f32x4){kv[4], kv[5], kv[6], kv[7]};
                *(f32x4*)(a.out + O_VS + o) = (f32x4){vv[0], vv[1], vv[2], vv[3]}; *(f32x4*)(a.out + O_VS + o + 4) = (f32x4){vv[4], vv[5], vv[6], vv[7]}; }
        }
        }
        __syncthreads();
        if (active) {
            const float slope = exp2f(-(float)(h + 1)) * 1.4426950408889634f, sink = sinks[h] * 1.4426950408889634f;
            const int nt0 = kstart >> 4, ntile = nkeys >> 4;
            const long qrow0 = qr0; const int qpos0 = samp ? (PAST + fr) : (c * 64 + 32 * th + fr);
            bf16x8 qf[2][4];
#pragma unroll
            for (int mt = 0; mt < 2; ++mt) { float qv[4][8]; float ss = 0.f;
#pragma unroll
                for (int ks = 0; ks < 4; ++ks) { const u32x4 w = qraw[mt][ks];
                    qv[ks][0] = bf_lo(w.x); qv[ks][1] = bf_hi(w.x); qv[ks][2] = bf_lo(w.y); qv[ks][3] = bf_hi(w.y); qv[ks][4] = bf_lo(w.z); qv[ks][5] = bf_hi(w.z); qv[ks][6] = bf_lo(w.w); qv[ks][7] = bf_hi(w.w);
#pragma unroll
                    for (int e = 0; e < 8; ++e) ss += qv[ks][e] * qv[ks][e]; }
                ss += __shfl_xor(ss, 16); ss += __shfl_xor(ss, 32);
                const float rs = rsqrtf(ss * (1.f / HD) + EPS) * (0.08838834764831845f * 1.4426950408889634f);
#pragma unroll
                for (int ks = 0; ks < 4; ++ks) { const float* gp = qg + 32 * ks + 8 * fq; float t[8];
#pragma unroll
                    for (int e = 0; e < 8; ++e) t[e] = qv[ks][e] * rs * gp[e];
                    u32x4 w; w.x = cvt_pk_bf16(t[0], t[1]); w.y = cvt_pk_bf16(t[2], t[3]); w.z = cvt_pk_bf16(t[4], t[5]); w.w = cvt_pk_bf16(t[6], t[7]);
                    qf[mt][ks] = __builtin_bit_cast(bf16x8, w); } }
            f32x4 s[2][12]; float mx0 = -INFINITY, mx1 = -INFINITY; const float fb0 = (float)(qpos0 - kpos0 - 4 * fq), fb1 = fb0 + 16.f;
#pragma unroll
            for (int n = 0; n < 12; ++n) {
                s[0][n] = (f32x4){-INFINITY, -INFINITY, -INFINITY, -INFINITY}; s[1][n] = s[0][n];
                if (n >= nt0 && n < ntile) {
                    f32x4 a0 = (f32x4){0.f, 0.f, 0.f, 0.f}, a1 = a0;
#pragma unroll
                    for (int ks = 0; ks < 4; ++ks) { const bf16x8 kf = *(const LAS bf16x8*)(lds + KS_OFF + (16 * n + fr) * KS_STRIDE + (32 * ks + 8 * fq) * 2);
                        a0 = __builtin_amdgcn_mfma_f32_16x16x32_bf16(kf, qf[0][ks], a0, 0, 0, 0); a1 = __builtin_amdgcn_mfma_f32_16x16x32_bf16(kf, qf[1][ks], a1, 0, 0, 0); }
#pragma unroll
                    for (int e = 0; e < 4; ++e) { const float kc = (float)(16 * n + e); float v0 = fmaf(-slope, fabsf(fb0 - kc), a0[e]), v1 = fmaf(-slope, fabsf(fb1 - kc), a1[e]);
                        if (samp && 16 * n + 4 * fq + e >= 144) { v0 = -INFINITY; v1 = -INFINITY; } s[0][n][e] = v0; s[1][n][e] = v1; mx0 = fmaxf(mx0, v0); mx1 = fmaxf(mx1, v1); }
                }
                if ((n & 3) == 3) __builtin_amdgcn_sched_barrier(0);
            }
            mx0 = fmaxf(mx0, __shfl_xor(mx0, 16)); mx0 = fmaxf(mx0, __shfl_xor(mx0, 32)); mx0 = fmaxf(mx0, sink);
            mx1 = fmaxf(mx1, __shfl_xor(mx1, 16)); mx1 = fmaxf(mx1, __shfl_xor(mx1, 32)); mx1 = fmaxf(mx1, sink);
            float sum0 = 0.f, sum1 = 0.f;
#pragma unroll
            for (int n = 0; n < 12; ++n)
#pragma unroll
                for (int e = 0; e < 4; ++e) { const float p0 = __builtin_amdgcn_exp2f(s[0][n][e] - mx0), p1 = __builtin_amdgcn_exp2f(s[1][n][e] - mx1); s[0][n][e] = p0; s[1][n][e] = p1; sum0 += p0; sum1 += p1; }
            sum0 += __shfl_xor(sum0, 16); sum0 += __shfl_xor(sum0, 32); sum1 += __shfl_xor(sum1, 16); sum1 += __shfl_xor(sum1, 32);
            const float inv0 = __builtin_amdgcn_rcpf(sum0 + __builtin_amdgcn_exp2f(sink - mx0)), inv1 = __builtin_amdgcn_rcpf(sum1 + __builtin_amdgcn_exp2f(sink - mx1));
            bf16x8 pf[2][6];
#pragma unroll
            for (int mt = 0; mt < 2; ++mt)
#pragma unroll
                for (int j = 0; j < 6; ++j) { u32x4 w; w.x = cvt_pk_bf16(s[mt][2 * j][0], s[mt][2 * j][1]); w.y = cvt_pk_bf16(s[mt][2 * j][2], s[mt][2 * j][3]);
                    w.z = cvt_pk_bf16(s[mt][2 * j + 1][0], s[mt][2 * j + 1][1]); w.w = cvt_pk_bf16(s[mt][2 * j + 1][2], s[mt][2 * j + 1][3]); pf[mt][j] = __builtin_bit_cast(bf16x8, w); }
#pragma unroll
            for (int dt = 0; dt < 8; ++dt) {
                f32x4 a0 = (f32x4){0.f, 0.f, 0.f, 0.f}, a1 = a0;
#pragma unroll
                for (int j = 0; j < 6; ++j) { if (2 * j >= nt0 && 2 * j < ntile) {
                    const int vsw = ((2 * dt + (fr >> 3)) & 7) << 2;
                    const LAS unsigned char* vp = lds + VT_OFF + (16 * dt + fr) * VT_STRIDE + 64 * j;
                    const u32x2 lo = *(const LAS u32x2*)(vp + ((4 * fq) ^ vsw) * 2), hi = *(const LAS u32x2*)(vp + ((4 * fq + 16) ^ vsw) * 2);
                    u32x4 w; w.x = lo.x; w.y = lo.y; w.z = hi.x; w.w = hi.y; const bf16x8 vf = __builtin_bit_cast(bf16x8, w);
                    a0 = __builtin_amdgcn_mfma_f32_16x16x32_bf16(vf, pf[0][j], a0, 0, 0, 0); a1 = __builtin_amdgcn_mfma_f32_16x16x32_bf16(vf, pf[1][j], a1, 0, 0, 0); } }
                u32x2 w; w.x = cvt_pk_bf16(a0[0] * inv0, a0[1] * inv0); w.y = cvt_pk_bf16(a0[2] * inv0, a0[3] * inv0);
                *(u32x2*)(YA + (size_t)qrow0 * DM + h * HD + 16 * dt + 4 * fq) = w;
                if (!samp) { w.x = cvt_pk_bf16(a1[0] * inv1, a1[1] * inv1); w.y = cvt_pk_bf16(a1[2] * inv1, a1[3] * inv1); *(u32x2*)(YA + (size_t)(qrow0 + 16) * DM + h * HD + 16 * dt + 4 * fq) = w; }
                if (dt & 1) __builtin_amdgcn_sched_barrier(0);
            }
        }
    }
    __syncthreads();
}

__device__ __forceinline__ void scan_agg(const Args& a, int G) {
    const bf16_t* LA = (const bf16_t*)(a.out); const bf16_t* BV = LA + (size_t)MTOT * DM;
    float* CA = (float*)(a.ws + WS_CA); float* CB = (float*)(a.ws + WS_CB);
    const int ch = 2 * threadIdx.x;
    for (int q = blockIdx.x; q < MP / 64; q += G) {
        const unsigned* lp = (const unsigned*)(LA + (size_t)q * 64 * DM + ch); const unsigned* bp = (const unsigned*)(BV + (size_t)q * 64 * DM + ch);
        float s0 = 0.f, s1 = 0.f, h0 = 0.f, h1 = 0.f;
        unsigned lw[64], bw[64];
#pragma unroll
        for (int t = 0; t < 64; ++t) { lw[t] = lp[(size_t)t * (DM / 2)]; bw[t] = bp[(size_t)t * (DM / 2)]; }
#pragma unroll
        for (int t = 0; t < 64; ++t) { const float l0 = bf_lo(lw[t]), l1 = bf_hi(lw[t]); s0 += l0; s1 += l1; h0 = __expf(l0) * h0 + bf_lo(bw[t]); h1 = __expf(l1) * h1 + bf_hi(bw[t]); }
        *(f32x2*)(CA + (size_t)q * DM + ch) = (f32x2){s0, s1}; *(f32x2*)(CB + (size_t)q * DM + ch) = (f32x2){h0, h1};
    }
}
__device__ __forceinline__ void scan_carry(const Args& a, int G) {
    const float* CA = (const float*)(a.ws + WS_CA); const float* CB = (const float*)(a.ws + WS_CB); float* CR = (float*)(a.ws + WS_CARRY);
    for (int i = blockIdx.x * NTHR + threadIdx.x; i < NBATCH * DM; i += G * NTHR) {
        const int b = i >> 10, ch = i & 1023; float carry = 0.f;
#pragma unroll 32
        for (int c = 0; c < NCH; ++c) { const size_t o = (size_t)(b * NCH + c) * DM + ch; CR[o] = carry; carry = __expf(CA[o]) * carry + CB[o]; }
        a.out[O_HP + (size_t)b * DM + ch] = carry;
    }
}
__device__ __forceinline__ void scan_full(const Args& a, int G) {
    const bf16_t* LA = (const bf16_t*)(a.out); const bf16_t* BV = LA + (size_t)MTOT * DM;
    const float* CR = (const float*)(a.ws + WS_CARRY); bf16_t* YR = (bf16_t*)(a.ws + WS_YR);
    const int ch = 2 * threadIdx.x;
    for (int q = blockIdx.x; q < MP / 64 + SBATCH; q += G) {
        const bool samp = q >= MP / 64; const int sb = q - MP / 64;
        const size_t row0 = samp ? (size_t)MP + (size_t)sb * SSEQ : (size_t)q * 64; const int n = samp ? SSEQ : 64;
        const unsigned* lp = (const unsigned*)(LA + row0 * DM + ch); const unsigned* bp = (const unsigned*)(BV + row0 * DM + ch); unsigned* yp = (unsigned*)(YR + row0 * DM + ch);
        f32x2 h = samp ? *(const f32x2*)(a.in[I_SRH] + (size_t)sb * DM + ch) : *(const f32x2*)(CR + (size_t)q * DM + ch);
        if (!samp) {
            unsigned lw[64], bw[64];
#pragma unroll
            for (int t = 0; t < 64; ++t) { lw[t] = lp[(size_t)t * (DM / 2)]; bw[t] = bp[(size_t)t * (DM / 2)]; }
#pragma unroll
            for (int t = 0; t < 64; ++t) { h.x = __expf(bf_lo(lw[t])) * h.x + bf_lo(bw[t]); h.y = __expf(bf_hi(lw[t])) * h.y + bf_hi(bw[t]); yp[(size_t)t * (DM / 2)] = cvt_pk_bf16(h.x, h.y); }
        } else {
#pragma unroll
            for (int t = 0; t < SSEQ; ++t) { const unsigned lw = lp[(size_t)t * (DM / 2)], bw = bp[(size_t)t * (DM / 2)];
                h.x = __expf(bf_lo(lw)) * h.x + bf_lo(bw); h.y = __expf(bf_hi(lw)) * h.y + bf_hi(bw); yp[(size_t)t * (DM / 2)] = cvt_pk_bf16(h.x, h.y); }
        }
        if (samp) *(f32x2*)(a.out + O_HS + (size_t)sb * DM + ch) = h;
    }
}

__device__ __forceinline__ void ffn_fix(const Args& a, int G) {
    bf16_t* Gb = (bf16_t*)(a.ws + WS_G);
    const float* HALO = (const float*)(a.ws + WS_HALO); const float* FIXA = (const float*)(a.ws + WS_FIXA); const float* FIXB = (const float*)(a.ws + WS_FIXB);
    const float* cw = a.in[I_FCW]; const float* cb = a.in[I_FCB];
    constexpr int NG4 = DFF / 4, NGRP = MP / 64;
    for (int it = blockIdx.x * NTHR + threadIdx.x; it < NGRP * NG4; it += G * NTHR) {
        const int g = it / NG4, j = (it - g * NG4) * 4;
        if ((g & (SEQ / 64 - 1)) == 0) continue;
        const f32x4 w0 = *(const f32x4*)(cw + j), w1 = *(const f32x4*)(cw + DFF + j), w2 = *(const f32x4*)(cw + 2 * DFF + j), bias = *(const f32x4*)(cb + j);
        const f32x4 h0 = *(const f32x4*)(HALO + ((size_t)(g - 1) * 2 + 0) * DFF + j), h1 = *(const f32x4*)(HALO + ((size_t)(g - 1) * 2 + 1) * DFF + j);
        const f32x4 a0 = *(const f32x4*)(FIXA + ((size_t)g * 2 + 0) * DFF + j), a1 = *(const f32x4*)(FIXA + ((size_t)g * 2 + 1) * DFF + j);
        const f32x4 b0 = *(const f32x4*)(FIXB + ((size_t)g * 2 + 0) * DFF + j), b1 = *(const f32x4*)(FIXB + ((size_t)g * 2 + 1) * DFF + j);
        const f32x4 y0 = h0 * w0 + h1 * w1 + a0 * w2 + bias, y1 = h1 * w0 + a0 * w1 + a1 * w2 + bias; f32x4 g0, g1;
#pragma unroll
        for (int e = 0; e < 4; ++e) { g0[e] = gelu_f(y0[e]) * b0[e]; g1[e] = gelu_f(y1[e]) * b1[e]; }
        u32x2 w; w.x = cvt_pk_bf16(g0[0], g0[1]); w.y = cvt_pk_bf16(g0[2], g0[3]); *(u32x2*)(Gb + (size_t)(g * 64) * DFF + j) = w;
        w.x = cvt_pk_bf16(g1[0], g1[1]); w.y = cvt_pk_bf16(g1[2], g1[3]); *(u32x2*)(Gb + (size_t)(g * 64 + 1) * DFF + j) = w;
    }
}

template <bool TWO, class F>
__device__ __forceinline__ void thin_tiles(const bf16_t* A0, const bf16_t* B0, const bf16_t* A1, const bf16_t* B1, int lda, int ldb, int K, int G, F&& epi) {
    const int lane = threadIdx.x & 63, wave = threadIdx.x >> 6, fr = lane & 15, fq = lane >> 4;
    constexpr int NTN = DM / 16;
    for (int t = wave * G + blockIdx.x; t < (MS / 16) * NTN; t += NWAVES * G) {
        const int tm = t / NTN, tn = t - tm * NTN, row0 = MP + 16 * tm, col0 = 16 * tn;
        const size_t ao = (size_t)(row0 + fr) * lda + 8 * fq, bo = (size_t)(col0 + fr) * ldb + 8 * fq;
        f32x4 acc0 = (f32x4){0.f, 0.f, 0.f, 0.f}, acc1 = acc0;
        for (int k = 0; k < K; k += 256) {
            bf16x8 av[8], bv[8], av1[8], bv1[8];
#pragma unroll
            for (int i = 0; i < 8; ++i) { av[i] = *(const bf16x8*)(A0 + ao + k + 32 * i); bv[i] = *(const bf16x8*)(B0 + bo + k + 32 * i);
                if (TWO) { av1[i] = *(const bf16x8*)(A1 + ao + k + 32 * i); bv1[i] = *(const bf16x8*)(B1 + bo + k + 32 * i); } }
#pragma unroll
            for (int i = 0; i < 8; ++i) { acc0 = __builtin_amdgcn_mfma_f32_16x16x32_bf16(bv[i], av[i], acc0, 0, 0, 0);
                if (TWO) acc1 = __builtin_amdgcn_mfma_f32_16x16x32_bf16(bv1[i], av1[i], acc1, 0, 0, 0); }
        }
        epi(row0 + fr, col0 + 4 * fq, acc0, acc1);
    }
}

constexpr int NPHASE = 12;
__global__ void __launch_bounds__(NTHR, 2) hawk_fwd(Args args) {
    extern __shared__ __attribute__((aligned(16))) unsigned char lds_raw[];
    LAS unsigned char* lds = (LAS unsigned char*)lds_raw;
    const int G = gridDim.x, lo = args.ph_lo, hi = args.ph_hi;
    unsigned char* ws = args.ws;
#ifndef ONLY_PHASE
#define ONLY_PHASE -1
#endif
#define IN(k) (lo <= (k) && (k) < hi && (ONLY_PHASE < 0 || ONLY_PHASE == (k)))
    volatile LAS unsigned* bst = (volatile LAS unsigned*)(lds + 131072);
    if (threadIdx.x < 2) bst[threadIdx.x] = 0u;
    __syncthreads();
    const XcdBarrier xbar = xcd_barrier_post((unsigned*)(ws + WS_BAR), bst);
#define SEAM(k) do { if (IN(k) && IN((k) + 1)) { if (hi > NPHASE) cg::this_grid().sync(); else xcd_barrier(xbar); } } while (0)
    if (IN(0)) { p0_prologue(args, lds, G, false); }
    SEAM(0);
    if (IN(1)) {
        pg8::Gemm g{(const bf16_t*)(ws + WS_XB), nullptr, (const bf16_t*)(ws + WS_WIN), DM, DM, DM, 1 << 30, 0};
        pg8::StaticOrder S; S.init(MTOT, INW, G, (int)blockIdx.x);
        pg8::EpiProj E{ws, args.out, args.in[I_BG], args.in[I_RCW], args.in[I_RCB], args.in[I_SRC]};
        pg8::gemm_phase<pg8::EpiProj, pg8::StaticOrder, true, true>(lds, g, S, E);
    }
    SEAM(1);
    if (IN(2)) { conv_fix(args, G); }
    SEAM(2);
    if (IN(3)) {
        pg8::Gemm g{(const bf16_t*)(ws + WS_UC), nullptr, (const bf16_t*)(ws + WS_WG), DM, RB, RB, 1 << 30, RB};
        pg8::StaticOrder S; S.init(MTOT, NRB * 256, G, (int)blockIdx.x);
        bf16_t* LA = (bf16_t*)args.out;
        pg8::EpiGates E{(const bf16_t*)(ws + WS_UC), LA, LA + (size_t)MTOT * DM, args.in[I_GAB], args.in[I_GXB], args.in[I_LAM]};
        pg8::gemm_phase<pg8::EpiGates, pg8::StaticOrder, true, true>(lds, g, S, E);
    }
    SEAM(3);
    if (IN(4)) scan_agg(args, G);
    SEAM(4);
    if (IN(5)) { scan_carry(args, G); p0_prologue(args, lds, G, true); }
    SEAM(5);
    if (IN(6)) {
        if (blockIdx.x & 1) { attn_phase(args, lds, G); scan_full(args, G); } else { scan_full(args, G); attn_phase(args, lds, G); }
    }
    SEAM(6);
    if (IN(7)) {
        pg8::Gemm g{(const bf16_t*)(ws + WS_YR), nullptr, (const bf16_t*)(ws + WS_WMIX), DM, 2048, 2048, 1 << 30, 0, (const bf16_t*)(ws + WS_YA), 16};
        { bf16_t* MIX = (bf16_t*)(ws + WS_MIX); const bf16_t* GT = (const bf16_t*)(ws + WS_GT);
          thin_tiles<true>((const bf16_t*)(ws + WS_YR), (const bf16_t*)(ws + WS_WMIX), (const bf16_t*)(ws + WS_YA), (const bf16_t*)(ws + WS_WMIX) + DM, DM, 2048, DM, G,
            [&](int row, int col, const f32x4& a0, const f32x4& a1) { const u32x2 gr = *(const u32x2*)(GT + (size_t)row * 2048 + col), ga = *(const u32x2*)(GT + (size_t)row * 2048 + 1024 + col);
                u32x2 w; w.x = cvt_pk_bf16(bf_lo(gr.x) * a0[0] + bf_lo(ga.x) * a1[0], bf_hi(gr.x) * a0[1] + bf_hi(ga.x) * a1[1]); w.y = cvt_pk_bf16(bf_lo(gr.y) * a0[2] + bf_lo(ga.y) * a1[2], bf_hi(gr.y) * a0[3] + bf_hi(ga.y) * a1[3]);
                *(u32x2*)(MIX + (size_t)row * DM + col) = w; }); }
        pg8::StaticOrder S; S.init(MP, DM, G, (int)blockIdx.x);
        pg8::EpiMix2 E{(bf16_t*)(ws + WS_MIX), (const bf16_t*)(ws + WS_GT)};
        pg8::gemm_phase<pg8::EpiMix2, pg8::StaticOrder, true, true>(lds, g, S, E);
    }
    SEAM(7);
    if (IN(8)) {
        pg8::Gemm g{(const bf16_t*)(ws + WS_MIX), nullptr, (const bf16_t*)(ws + WS_WOUT), DM, DM, DM, 1 << 30, 0};
        { const float* xs = args.in[I_XS]; float* OUTY = args.out; bf16_t* X1B = (bf16_t*)(ws + WS_X1B); float* rss2 = (float*)(ws + WS_RSS2);
          thin_tiles<false>((const bf16_t*)(ws + WS_MIX), (const bf16_t*)(ws + WS_WOUT), nullptr, nullptr, DM, DM, DM, G,
            [&](int row, int col, const f32x4& a0, const f32x4&) { const f32x4 o = *(const f32x4*)(xs + (size_t)(row - MP) * DM + col) + a0;
                u32x2 w; w.x = cvt_pk_bf16(o[0], o[1]); w.y = cvt_pk_bf16(o[2], o[3]); *(u32x2*)(X1B + (size_t)row * DM + col) = w;
                float ss = (o[0] * o[0] + o[1] * o[1]) + (o[2] * o[2] + o[3] * o[3]); ss += __shfl_xor(ss, 16); ss += __shfl_xor(ss, 32); if ((threadIdx.x & 48) == 0) atomicAdd(rss2 + row, ss); }); }
        pg8::StaticOrder S; S.init(MP, DM, G, (int)blockIdx.x);
        pg8::EpiOut E{args.in[I_XP], args.in[I_XS], args.out, (bf16_t*)(ws + WS_X1B), (float*)(ws + WS_RSS2)};
        pg8::gemm_phase<pg8::EpiOut, pg8::StaticOrder, true, true>(lds, g, S, E);
    }
    SEAM(8);
    if (IN(9)) {
        pg8::Gemm g{(const bf16_t*)(ws + WS_X1B), nullptr, (const bf16_t*)(ws + WS_WUP), DM, DM, DM, 1 << 30, 0};
        pg8::StaticOrder S; S.init(MTOT, UPW, G, (int)blockIdx.x);
        pg8::EpiUpF E{(bf16_t*)(ws + WS_G), (const float*)(ws + WS_RSS2), args.in[I_FCW], args.in[I_FCB], args.in[I_SFC], args.out, (float*)(ws + WS_HALO), (float*)(ws + WS_FIXA), (float*)(ws + WS_FIXB)};
        pg8::gemm_phase<pg8::EpiUpF, pg8::StaticOrder, true, true>(lds, g, S, E);
    }
    SEAM(9);
    if (IN(10)) ffn_fix(args, G);
    SEAM(10);
    if (IN(11)) {
        pg8::Gemm g{(const bf16_t*)(ws + WS_G), nullptr, (const bf16_t*)(ws + WS_WDN), DFF, DFF, DFF, 1 << 30, 0};
        { float* OUTY = args.out;
          thin_tiles<false>((const bf16_t*)(ws + WS_G), (const bf16_t*)(ws + WS_WDN), nullptr, nullptr, DFF, DFF, DFF, G,
            [&](int row, int col, const f32x4& a0, const f32x4&) { const u32x2 xw = *(const u32x2*)((const bf16_t*)(ws + WS_X1B) + (size_t)row * DM + col);
                *(f32x4*)(OUTY + (size_t)row * DM + col) = (f32x4){bf_lo(xw.x), bf_hi(xw.x), bf_lo(xw.y), bf_hi(xw.y)} + a0; }); }
        pg8::StaticOrder S; S.init(MP, DM, G, (int)blockIdx.x);
        pg8::EpiDown E{args.out, (const bf16_t*)(ws + WS_X1B)};
        pg8::gemm_phase<pg8::EpiDown, pg8::StaticOrder, true, true>(lds, g, S, E);
    }
#undef IN
#undef SEAM
}

extern "C" void kernel_launch(void* const* d_in, const int* in_sizes, int n_in, void* d_out, int out_size, void* d_ws, size_t ws_size, hipStream_t stream) {
    static int grid = 0;
    if (grid == 0) {
        if (n_in != 28 || (size_t)out_size != O_END || ws_size < WS_END2) { fprintf(stderr, "kernel_launch: unexpected sizes: n_in %d out %d ws %zu (need %zu)\n", n_in, out_size, ws_size, (size_t)WS_END2); grid = -1; return; }
        int dev = 0, cus = 0, per_cu = 0;
        hipGetDevice(&dev); hipDeviceGetAttribute(&cus, hipDeviceAttributeMultiprocessorCount, dev);
        if (hipFuncSetAttribute((const void*)hawk_fwd, hipFuncAttributeMaxDynamicSharedMemorySize, LDS_BYTES) != hipSuccess) { fprintf(stderr, "kernel_launch: hipFuncSetAttribute failed\n"); grid = -1; return; }
        if (hipOccupancyMaxActiveBlocksPerMultiprocessor(&per_cu, (const void*)hawk_fwd, NTHR, LDS_BYTES) != hipSuccess || per_cu < 1) { fprintf(stderr, "kernel_launch: occupancy query says %d\n", per_cu); per_cu = 1; }
        (void)hipGetLastError();
        grid = cus;
    }
    if (grid < 0) return;
    if (hipMemsetAsync((char*)d_ws + WS_BAR, 0, XCD_BAR_WORDS * 4, stream) != hipSuccess) { fprintf(stderr, "kernel_launch: memset failed\n"); return; }
    Args a{};
    for (int i = 0; i < 28; ++i) a.in[i] = (const float*)d_in[i];
    a.out = (float*)d_out; a.ws = (unsigned char*)d_ws;
#if ONE_LAUNCH
    a.ph_lo = 0; a.ph_hi = NPHASE;
    void* kargs[] = {&a};
    hipError_t e = hipLaunchCooperativeKernel((const void*)hawk_fwd, dim3(grid), dim3(NTHR), kargs, LDS_BYTES, stream);
    if (e != hipSuccess) fprintf(stderr, "kernel_launch: cooperative launch failed: %s (grid %d)\n", hipGetErrorString(e), grid);
#else
    for (int p = 0; p < NPHASE; ++p) { a.ph_lo = p; a.ph_hi = p + 1; hipLaunchKernelGGL(hawk_fwd, dim3(grid), dim3(NTHR), LDS_BYTES, stream, a); }
#endif
}
```

```cpp
#include <hip/hip_runtime.h>
#include <hip/hip_cooperative_groups.h>
#include <cstdio>
#include <cstdint>
namespace cg = cooperative_groups;

#ifndef ONE_LAUNCH
#define ONE_LAUNCH 1
#endif

constexpr int DM = 1024, NBATCH = 8, SEQ = 8192, MP = NBATCH * SEQ, SBATCH = 16, SSEQ = 16, MS = SBATCH * SSEQ, MTOT = MP + MS;
constexpr int NH = 8, NKV = 2, HD = 128, GRP = 4, WIN = 128, CHUNK = 64, NCH = SEQ / CHUNK;
constexpr int INW = 4608, DFF = 2816, UPW = 2 * DFF, NRB = 8, RB = 128;
constexpr float EPS = 1e-6f;
constexpr int PAST = 1024;

constexpr size_t O_YP = 0, O_YS = O_YP + (size_t)MP * DM, O_RCP = O_YS + (size_t)MS * DM, O_RCS = O_RCP + (size_t)NBATCH * 3 * DM,
                 O_HP = O_RCS + (size_t)SBATCH * 3 * DM, O_HS = O_HP + (size_t)NBATCH * DM, O_KP = O_HS + (size_t)SBATCH * DM,
                 O_KS = O_KP + (size_t)NBATCH * WIN * NKV * HD, O_VP = O_KS + (size_t)SBATCH * WIN * NKV * HD, O_VS = O_VP + (size_t)NBATCH * WIN * NKV * HD,
                 O_FCP = O_VS + (size_t)SBATCH * WIN * NKV * HD, O_FCS = O_FCP + (size_t)NBATCH * 2 * DFF, O_END = O_FCS + (size_t)SBATCH * 2 * DFF;

constexpr size_t MiB = 1u << 20;
constexpr size_t WS_WIN = 0, WS_WMIX = WS_WIN + (size_t)INW * DM * 2, WS_WOUT = WS_WMIX + (size_t)2048 * DM * 2, WS_WUP = WS_WOUT + (size_t)DM * DM * 2,
                 WS_WDN = WS_WUP + (size_t)UPW * DM * 2, WS_WG = WS_WDN + (size_t)DM * DFF * 2, WS_WEND = WS_WG + (size_t)NRB * 256 * RB * 2;
static_assert(WS_WEND == 32 * MiB, "weights region");
constexpr size_t WS_BAR = 32 * MiB + 512 * 1024;
constexpr size_t WS_RSS2 = 32 * MiB, WS_CA = 33 * MiB, WS_CB = 37 * MiB, WS_CARRY = 41 * MiB;
constexpr size_t ROWB = (size_t)MTOT * 2;
constexpr size_t WS_BIG = 48 * MiB;
constexpr size_t WS_U = WS_BIG, WS_Q = WS_U + ROWB * 1024, WS_KV = WS_Q + ROWB * 1024, WS_GT = WS_KV + ROWB * 512, WS_YA = WS_GT + ROWB * 2048, WS_BIGEND = WS_YA + ROWB * 1024;
constexpr size_t WS_AB = WS_BIG;
static_assert(WS_BIGEND - WS_BIG == ROWB * UPW, "AB overlay");
constexpr size_t WS_YR = WS_U, WS_MIX = WS_Q;
constexpr size_t WS_XB = WS_BIGEND, WS_UC = WS_U, WS_X1B = WS_XB, WS_END = WS_XB + ROWB * 1024;
constexpr size_t WS_G = WS_BIG;
constexpr size_t WS_HALO = WS_END, WS_FIXA = WS_HALO + 24 * MiB, WS_FIXB = WS_FIXA + 24 * MiB, WS_HALOU = WS_FIXB + 24 * MiB, WS_FIXU = WS_HALOU + 12 * MiB, WS_END2 = WS_FIXU + 12 * MiB;
static_assert(WS_END2 <= 1024 * MiB, "d_ws map must fit 1 GiB");

#define LAS __attribute__((address_space(3)))
typedef unsigned short bf16_t;
typedef short bf16x8 __attribute__((ext_vector_type(8)));
typedef float f32x4 __attribute__((ext_vector_type(4)));
typedef float f32x2 __attribute__((ext_vector_type(2)));
typedef unsigned u32x4 __attribute__((ext_vector_type(4)));
typedef unsigned u32x2 __attribute__((ext_vector_type(2)));

typedef __bf16 bf16x2_t __attribute__((ext_vector_type(2)));
__device__ __forceinline__ unsigned cvt_pk_bf16(float lo, float hi) { const f32x2 v = {lo, hi}; return __builtin_bit_cast(unsigned, __builtin_convertvector(v, bf16x2_t)); }
__device__ __forceinline__ float bf_lo(unsigned w) { return __uint_as_float(w << 16); }
__device__ __forceinline__ float bf_hi(unsigned w) { return __uint_as_float(w & 0xffff0000u); }
__device__ __forceinline__ float bf1(bf16_t b) { return __uint_as_float((unsigned)b << 16); }
__device__ __forceinline__ float sigmoidf_(float v) { return __builtin_amdgcn_rcpf(1.0f + __expf(-v)); }

__device__ __forceinline__ float gelu_f(float v) {
    const float av = fabsf(v), t = __builtin_amdgcn_rcpf(av * 0.2316418882f + 1.0f);
    float q = t * 0.5307027145f + (-0.7265760135f); q = q * t + 0.7107068705f; q = q * t + (-0.142248368f); q = q * t + 0.127414796f; q = q * t;
    const float e = __builtin_amdgcn_exp2f((v * v) * (-0.72134752044f)), m = v * (q * e);
    return v < 0.f ? m : v - m;
}
template <int N> __device__ __forceinline__ float row_ror(float v) { return __builtin_bit_cast(float, __builtin_amdgcn_update_dpp(0, __builtin_bit_cast(int, v), 0x120 + N, 0xf, 0xf, false)); }

namespace pg8 {
#define PG8_LAS __attribute__((address_space(3)))
constexpr int BM = 256, BK = 64, HALF = 128, HTB = HALF * BK * 2  , STAGE_BYTES = 8 * HTB, NXCD = 8, WGM = 8;

__host__ __device__ __forceinline__ int lds_byte(int r, int c) { const int st = (r >> 4) * 2 + (c >> 5), rr = r & 15, cc = c & 31, ob = rr * 64 + cc * 2; return st * 1024 + (ob ^ (((ob >> 9) & 1) << 5)); }
__host__ __device__ __forceinline__ void stage_rc(int b, int& R, int& C) { const int st = b / 1024, sb = b % 1024, swz = sb ^ (((sb >> 9) & 1) << 5); R = (st >> 1) * 16 + swz / 64; C = (st & 1) * 32 + (swz % 64) / 2; }
__host__ __device__ __forceinline__ int perm32(int rho) { const int n = rho >> 4, i = rho & 15; return 8 * (i >> 2) + 4 * n + (i & 3); }

struct Unit { int pm, pn; };
struct Gemm {
    const bf16_t* A; const bf16_t* A2; const bf16_t* Bt; int lda, ldb, K, a2_from, a_col_step;
    const bf16_t* A3 = nullptr; int ksplit = 0;
    __device__ __forceinline__ const char* a3_ptr(const Unit& u) const { return (const char*)(A3 + (size_t)u.pm * BM * lda) - (size_t)ksplit * (BK * 2); }
    __device__ __forceinline__ const char* a_ptr(const Unit& u) const { return (const char*)((u.pn >= a2_from ? A2 : A) + (size_t)u.pm * BM * lda + (size_t)u.pn * a_col_step); }
    __device__ __forceinline__ const char* b_ptr(const Unit& u) const { return (const char*)(Bt + (size_t)u.pn * BM * ldb); }
};

struct StaticOrder {
    int nM, nN, nwg, G, c;
    __host__ __device__ void init(int M, int N, int G_, int c_) { nM = M / BM; nN = N / BM; nwg = nM * nN; G = G_; c = c_; }
    __host__ __device__ bool next(int i, Unit& u) const {
        const long L = (long)i * G + c; if (L >= nwg) return false;
        int wgid = (int)L; { const int q = nwg / NXCD, r = nwg % NXCD, xcd = wgid % NXCD, off = wgid / NXCD; wgid = (xcd < r ? xcd * (q + 1) : r * (q + 1) + (xcd - r) * q) + off; }
        const int nig = WGM * nN, gid = wgid / nig, fm = gid * WGM, gsz = (nM - fm) < WGM ? (nM - fm) : WGM;
        u.pm = fm + ((wgid % nig) % gsz); u.pn = (wgid % nig) / gsz; return true;
    }
    __device__ __forceinline__ void a_ready(const Unit&) const {}
    __device__ __forceinline__ void done(const Unit&) const {}
};
struct PairOrder {
    StaticOrder so;
    __device__ bool next(int j, Unit& u) const { if (!so.next(j >> 1, u)) return false; u.pn += 4 * (j & 1); return true; }
    __device__ __forceinline__ void a_ready(const Unit&) const {}
    __device__ __forceinline__ void done(const Unit&) const {}
};


struct EpiProj {
    static constexpr bool PERM = true, AFTER_DRAIN = false, HAS_MID = false;
    unsigned char* ws; float* out; const float *bgate, *cw, *cb, *st;
    __device__ __forceinline__ void conv_tile(const f32x4 (&acc)[2][2][4][2], const Unit& u, int wr, int wc, int fr, int fq) const {
        const bool samp = u.pm == MP / BM; const int rowb = u.pm * BM + wr * 64 + fr;
        bf16_t* U = (bf16_t*)(ws + WS_UC); float* HALOU = (float*)(ws + WS_HALOU); float* FIXU = (float*)(ws + WS_FIXU);
#pragma unroll
        for (int bj = 0; bj < 2; ++bj)
#pragma unroll
        for (int n = 0; n < 2; ++n) {
            const int c = u.pn * BM + bj * HALF + wc * 32 + 8 * fq + 4 * n;
            const f32x4 w0 = *(const f32x4*)(cw + c), w1 = *(const f32x4*)(cw + DM + c), w2 = *(const f32x4*)(cw + 2 * DM + c), w3 = *(const f32x4*)(cw + 3 * DM + c), bias = *(const f32x4*)(cb + c);
#pragma unroll
            for (int ai = 0; ai < 2; ++ai) {
#pragma unroll
                for (int m = 0; m < 4; ++m) {
                    const int row = rowb + ai * HALF + m * 16; const f32x4 av = acc[ai][bj][m][n], pv = acc[ai][bj][m > 0 ? m - 1 : 0][n];
                    f32x4 p1, p2, p3; bool fix = false;
#pragma unroll
                    for (int e = 0; e < 4; ++e) { p1[e] = row_ror<1>(av[e]); p2[e] = row_ror<2>(av[e]); p3[e] = row_ror<3>(av[e]); }
                    if (samp) {
                        if (fr < 3) { const float* sp = st + (size_t)((row - MP) >> 4) * 3 * DM + c; const f32x4 s0 = *(const f32x4*)sp, s1 = *(const f32x4*)(sp + DM), s2 = *(const f32x4*)(sp + 2 * DM);
                            if (fr == 0) { p1 = s2; p2 = s1; p3 = s0; } else if (fr == 1) { p2 = s2; p3 = s1; } else p3 = s2; }
                    } else if (m > 0) {
#pragma unroll
                        for (int e = 0; e < 4; ++e) { const float q1 = row_ror<1>(pv[e]), q2 = row_ror<2>(pv[e]), q3 = row_ror<3>(pv[e]); if (fr < 1) p1[e] = q1; if (fr < 2) p2[e] = q2; if (fr < 3) p3[e] = q3; }
                    } else if (fr < 3) {
                        if ((row & (SEQ - 1)) < 3) { const f32x4 z = (f32x4){0.f, 0.f, 0.f, 0.f}; if (fr < 1) p1 = z; if (fr < 2) p2 = z; p3 = z; }
                        else fix = true;
                    }
                    if (fix) *(f32x4*)(FIXU + ((size_t)(row >> 6) * 3 + fr) * DM + c) = av;
                    else { const f32x4 y = p3 * w0 + p2 * w1 + p1 * w2 + av * w3 + bias; u32x2 w; w.x = cvt_pk_bf16(y[0], y[1]); w.y = cvt_pk_bf16(y[2], y[3]); *(u32x2*)(U + (size_t)row * DM + c) = w; }
                    if (!samp) {
                        if (m == 3 && fr >= 13) { *(f32x4*)(HALOU + ((size_t)(row >> 6) * 3 + (fr - 13)) * DM + c) = av;
                            if ((row & (SEQ - 1)) >= SEQ - 3) *(f32x4*)(out + O_RCP + ((size_t)(row >> 13) * 3 + (fr - 13)) * DM + c) = av; }
                    } else if (fr >= 13) *(f32x4*)(out + O_RCS + ((size_t)((row - MP) >> 4) * 3 + (fr - 13)) * DM + c) = av;
                }
            }
        }
    }
    __device__ __forceinline__ void operator()(const f32x4 (&acc)[2][2][4][2], const Unit& u, int wr, int wc, int fr, int fq) const {
        const int pn = u.pn; bf16_t* base; int ldc, colt; bool sig = false;
        if (pn < 4) { conv_tile(acc, u, wr, wc, fr, fq); return; }
        if (pn < 8) { base = (bf16_t*)(ws + WS_Q); ldc = 1024; colt = (pn - 4) * 256; }
        else if (pn < 10) { base = (bf16_t*)(ws + WS_KV); ldc = 512; colt = (pn - 8) * 256; } else { base = (bf16_t*)(ws + WS_GT); ldc = 2048; colt = (pn - 10) * 256; sig = true; }
        const int row0 = u.pm * BM + wr * 64 + fr, col0 = colt + wc * 32 + 8 * fq;
        f32x4 bv[2][2];
#pragma unroll
        for (int bj = 0; bj < 2; ++bj)
#pragma unroll
            for (int n = 0; n < 2; ++n) bv[bj][n] = sig ? *(const f32x4*)(bgate + col0 + bj * HALF + 4 * n) : (f32x4){0.f, 0.f, 0.f, 0.f};
#pragma unroll
        for (int ai = 0; ai < 2; ++ai)
#pragma unroll
            for (int m = 0; m < 4; ++m) { bf16_t* rowp = base + (size_t)(row0 + ai * HALF + m * 16) * ldc + col0;
#pragma unroll
                for (int bj = 0; bj < 2; ++bj) { f32x4 v0 = acc[ai][bj][m][0] + bv[bj][0], v1 = acc[ai][bj][m][1] + bv[bj][1];
                    if (sig) {
#pragma unroll
                        for (int e = 0; e < 4; ++e) { v0[e] = sigmoidf_(v0[e]); v1[e] = sigmoidf_(v1[e]); } }
                    u32x4 w; w.x = cvt_pk_bf16(v0[0], v0[1]); w.y = cvt_pk_bf16(v0[2], v0[3]); w.z = cvt_pk_bf16(v1[0], v1[1]); w.w = cvt_pk_bf16(v1[2], v1[3]);
                    *(u32x4*)(rowp + bj * HALF) = w; } }
    }
};
struct EpiUpF {
    static constexpr bool PERM = true, AFTER_DRAIN = false, HAS_MID = false;
    bf16_t* Gb; const float* rss2; const float* cw; const float* cb; const float* st; float* out; float* HALO; float* FIXA; float* FIXB;
    __device__ __forceinline__ void operator()(const f32x4 (&acc)[2][2][4][2], const Unit& u, int wr, int wc, int fr, int fq) const {
        const bool samp = u.pm == MP / BM;
        const int j0 = u.pn * HALF + wc * 32 + 8 * fq, rowb = u.pm * BM + wr * 64 + fr;
        float rs[2][4];
#pragma unroll
        for (int ai = 0; ai < 2; ++ai)
#pragma unroll
            for (int m = 0; m < 4; ++m) rs[ai][m] = rsqrtf(rss2[rowb + ai * HALF + m * 16] * (1.0f / DM) + EPS);
#pragma unroll
        for (int n = 0; n < 2; ++n) {
            const int j = j0 + 4 * n;
            const f32x4 w0 = *(const f32x4*)(cw + j), w1 = *(const f32x4*)(cw + DFF + j), w2 = *(const f32x4*)(cw + 2 * DFF + j), bias = *(const f32x4*)(cb + j);
#pragma unroll
            for (int ai = 0; ai < 2; ++ai) {
                f32x4 av[4], r1[4], r2[4];
#pragma unroll
                for (int m = 0; m < 4; ++m) { av[m] = acc[ai][0][m][n] * rs[ai][m];
#pragma unroll
                    for (int e = 0; e < 4; ++e) { r1[m][e] = row_ror<1>(av[m][e]); r2[m][e] = row_ror<2>(av[m][e]); } }
#pragma unroll
                for (int m = 0; m < 4; ++m) {
                    const int row = rowb + ai * HALF + m * 16;
                    const f32x4 bvv = acc[ai][1][m][n] * rs[ai][m];
                    f32x4 p1 = r1[m], p2 = r2[m]; bool fix = false;
                    if (samp) {
                        if (fr < 2) { const float* sp = st + (size_t)((row - MP) >> 4) * 2 * DFF + j; const f32x4 s0 = *(const f32x4*)sp, s1 = *(const f32x4*)(sp + DFF);
                            if (fr == 0) { p1 = s1; p2 = s0; } else p2 = s1; }
                    } else if (m > 0) { if (fr < 1) p1 = r1[m - 1]; if (fr < 2) p2 = r2[m - 1]; }
                    else if (fr < 2) {
                        if ((row & (SEQ - 1)) < 2) { const f32x4 z = (f32x4){0.f, 0.f, 0.f, 0.f}; if (fr == 0) p1 = z; p2 = z; }
                        else fix = true;
                    }
                    if (fix) { const size_t o = ((size_t)(row >> 6) * 2 + fr) * DFF + j; *(f32x4*)(FIXA + o) = av[m]; *(f32x4*)(FIXB + o) = bvv; }
                    else {
                        const f32x4 y = p2 * w0 + p1 * w1 + av[m] * w2 + bias; f32x4 g;
#pragma unroll
                        for (int e = 0; e < 4; ++e) g[e] = gelu_f(y[e]) * bvv[e];
                        u32x2 w; w.x = cvt_pk_bf16(g[0], g[1]); w.y = cvt_pk_bf16(g[2], g[3]); *(u32x2*)(Gb + (size_t)row * DFF + j) = w;
                    }
                    if (!samp) {
                        if (m == 3 && fr >= 14) { *(f32x4*)(HALO + ((size_t)(row >> 6) * 2 + (fr - 14)) * DFF + j) = av[m];
                            if ((row & (SEQ - 1)) >= SEQ - 2) *(f32x4*)(out + O_FCP + ((size_t)(row >> 13) * 2 + (fr - 14)) * DFF + j) = av[m]; }
                    } else if (fr >= 14) *(f32x4*)(out + O_FCS + ((size_t)((row - MP) >> 4) * 2 + (fr - 14)) * DFF + j) = av[m];
                }
            }
        }
    }
};
struct EpiMix {
    static constexpr bool PERM = true, AFTER_DRAIN = false, HAS_MID = false;
    bf16_t* MIX; const bf16_t* GT;
    __device__ __forceinline__ void operator()(const f32x4 (&acc)[2][2][4][2], const Unit& u, int wr, int wc, int fr, int fq) const {
        const int seg = u.pn >> 2, row0 = u.pm * BM + wr * 64 + fr, col0 = (u.pn & 3) * BM + wc * 32 + 8 * fq;
#pragma unroll
        for (int ai = 0; ai < 2; ++ai)
#pragma unroll
            for (int m = 0; m < 4; ++m) { const int row = row0 + ai * HALF + m * 16; bf16_t* rowp = MIX + (size_t)row * 1024 + col0; const bf16_t* gp = GT + (size_t)row * 2048 + seg * 1024 + col0;
#pragma unroll
                for (int bj = 0; bj < 2; ++bj) { const u32x4 g = *(const u32x4*)(gp + bj * HALF);
                    f32x4 v0 = acc[ai][bj][m][0], v1 = acc[ai][bj][m][1];
                    v0[0] *= bf_lo(g.x); v0[1] *= bf_hi(g.x); v0[2] *= bf_lo(g.y); v0[3] *= bf_hi(g.y); v1[0] *= bf_lo(g.z); v1[1] *= bf_hi(g.z); v1[2] *= bf_lo(g.w); v1[3] *= bf_hi(g.w);
                    if (seg) { const u32x4 p = *(const u32x4*)(rowp + bj * HALF);
                        v0[0] += bf_lo(p.x); v0[1] += bf_hi(p.x); v0[2] += bf_lo(p.y); v0[3] += bf_hi(p.y); v1[0] += bf_lo(p.z); v1[1] += bf_hi(p.z); v1[2] += bf_lo(p.w); v1[3] += bf_hi(p.w); }
                    u32x4 w; w.x = cvt_pk_bf16(v0[0], v0[1]); w.y = cvt_pk_bf16(v0[2], v0[3]); w.z = cvt_pk_bf16(v1[0], v1[1]); w.w = cvt_pk_bf16(v1[2], v1[3]);
                    *(u32x4*)(rowp + bj * HALF) = w; } }
    }
};
struct EpiMix2 {
    static constexpr bool PERM = true, AFTER_DRAIN = false, HAS_MID = true;
    bf16_t* MIX; const bf16_t* GT;
    __device__ __forceinline__ void mid(f32x4 (&acc)[2][2][4][2], const Unit& u, int wr, int wc, int fr, int fq) const {
        const int row0 = u.pm * BM + wr * 64 + fr, col0 = u.pn * BM + wc * 32 + 8 * fq;
#pragma unroll
        for (int ai = 0; ai < 2; ++ai)
#pragma unroll
            for (int m = 0; m < 4; ++m) { const bf16_t* gp = GT + (size_t)(row0 + ai * HALF + m * 16) * 2048 + col0;
#pragma unroll
                for (int bj = 0; bj < 2; ++bj) { const u32x4 gr = *(const u32x4*)(gp + bj * HALF), ga = *(const u32x4*)(gp + 1024 + bj * HALF);
                    const float r[8] = {bf_lo(gr.x), bf_hi(gr.x), bf_lo(gr.y), bf_hi(gr.y), bf_lo(gr.z), bf_hi(gr.z), bf_lo(gr.w), bf_hi(gr.w)};
                    const float q[8] = {bf_lo(ga.x), bf_hi(ga.x), bf_lo(ga.y), bf_hi(ga.y), bf_lo(ga.z), bf_hi(ga.z), bf_lo(ga.w), bf_hi(ga.w)};
#pragma unroll
                    for (int e = 0; e < 4; ++e) { acc[ai][bj][m][0][e] *= r[e] * __builtin_amdgcn_rcpf(fmaxf(q[e], 1e-30f)); acc[ai][bj][m][1][e] *= r[4 + e] * __builtin_amdgcn_rcpf(fmaxf(q[4 + e], 1e-30f)); } }
                if (m & 1) asm volatile("" ::: "memory"); }
    }
    __device__ __forceinline__ void operator()(const f32x4 (&acc)[2][2][4][2], const Unit& u, int wr, int wc, int fr, int fq) const {
        const int row0 = u.pm * BM + wr * 64 + fr, col0 = u.pn * BM + wc * 32 + 8 * fq;
#pragma unroll
        for (int ai = 0; ai < 2; ++ai)
#pragma unroll
            for (int m = 0; m < 4; ++m) { const int row = row0 + ai * HALF + m * 16; const bf16_t* gp = GT + (size_t)row * 2048 + 1024 + col0;
#pragma unroll
                for (int bj = 0; bj < 2; ++bj) { const u32x4 ga = *(const u32x4*)(gp + bj * HALF);
                    const float q[8] = {bf_lo(ga.x), bf_hi(ga.x), bf_lo(ga.y), bf_hi(ga.y), bf_lo(ga.z), bf_hi(ga.z), bf_lo(ga.w), bf_hi(ga.w)}; float v[8];
#pragma unroll
                    for (int e = 0; e < 4; ++e) { v[e] = acc[ai][bj][m][0][e] * fmaxf(q[e], 1e-30f); v[4 + e] = acc[ai][bj][m][1][e] * fmaxf(q[4 + e], 1e-30f); }
                    u32x4 w; w.x = cvt_pk_bf16(v[0], v[1]); w.y = cvt_pk_bf16(v[2], v[3]); w.z = cvt_pk_bf16(v[4], v[5]); w.w = cvt_pk_bf16(v[6], v[7]);
                    *(u32x4*)(MIX + (size_t)row * DM + col0 + bj * HALF) = w; } }
    }
};
struct EpiOut {
    static constexpr bool PERM = true, AFTER_DRAIN = false, HAS_MID = false;
    const float* xp; const float* xs; float* OUTY; bf16_t* X1B; float* rss2;
    __device__ __forceinline__ void operator()(const f32x4 (&acc)[2][2][4][2], const Unit& u, int wr, int wc, int fr, int fq) const {
        const int col0 = u.pn * BM + wc * 32 + 8 * fq;
#pragma unroll
        for (int ai = 0; ai < 2; ++ai)
#pragma unroll
            for (int m = 0; m < 4; ++m) { const int row = u.pm * BM + ai * HALF + wr * 64 + m * 16 + fr;
                const float* xrow = (row < MP) ? xp + (size_t)row * DM : xs + (size_t)(row - MP) * DM; float ss = 0.f;
#pragma unroll
                for (int bj = 0; bj < 2; ++bj) { const int c = col0 + bj * HALF;
                    const f32x4 o0 = __builtin_nontemporal_load((const f32x4*)(xrow + c)) + acc[ai][bj][m][0], o1 = __builtin_nontemporal_load((const f32x4*)(xrow + c + 4)) + acc[ai][bj][m][1];
                    ss += ((o0[0] * o0[0] + o0[1] * o0[1]) + (o0[2] * o0[2] + o0[3] * o0[3])) + ((o1[0] * o1[0] + o1[1] * o1[1]) + (o1[2] * o1[2] + o1[3] * o1[3]));
                    u32x4 w; w.x = cvt_pk_bf16(o0[0], o0[1]); w.y = cvt_pk_bf16(o0[2], o0[3]); w.z = cvt_pk_bf16(o1[0], o1[1]); w.w = cvt_pk_bf16(o1[2], o1[3]); *(u32x4*)(X1B + (size_t)row * DM + c) = w; }
                ss += __shfl_xor(ss, 16); ss += __shfl_xor(ss, 32);
                if (fq == 0) atomicAdd(rss2 + row, ss);
                if (m & 1) asm volatile("" ::: "memory"); }
    }
};
struct EpiDown {
    static constexpr bool PERM = true, AFTER_DRAIN = false, HAS_MID = false;
    float* OUTY; const bf16_t* X1B;
    __device__ __forceinline__ void operator()(const f32x4 (&acc)[2][2][4][2], const Unit& u, int wr, int wc, int fr, int fq) const {
        const int col0 = u.pn * BM + wc * 32 + 8 * fq;
#pragma unroll
        for (int ai = 0; ai < 2; ++ai)
#pragma unroll
            for (int m = 0; m < 4; ++m) { float* orow = OUTY + (size_t)(u.pm * BM + ai * HALF + wr * 64 + m * 16 + fr) * DM + col0;
#pragma unroll
                for (int bj = 0; bj < 2; ++bj) { float* p = orow + bj * HALF; const u32x4 xw = __builtin_nontemporal_load((const u32x4*)(X1B + (p - OUTY)));
                    __builtin_nontemporal_store((f32x4){bf_lo(xw.x), bf_hi(xw.x), bf_lo(xw.y), bf_hi(xw.y)} + acc[ai][bj][m][0], (f32x4*)p);
                    __builtin_nontemporal_store((f32x4){bf_lo(xw.z), bf_hi(xw.z), bf_lo(xw.w), bf_hi(xw.w)} + acc[ai][bj][m][1], (f32x4*)(p + 4)); }
                if (m & 1) asm volatile("" ::: "memory"); }
    }
};
struct EpiGates {
    static constexpr bool PERM = true, AFTER_DRAIN = false, HAS_MID = false;
    const bf16_t* UC; bf16_t* LA; bf16_t* BV; const float *ba, *bx, *lam;
    __device__ __forceinline__ void operator()(const f32x4 (&acc)[2][2][4][2], const Unit& u, int wr, int wc, int fr, int fq) const {
        const int ch0 = u.pn * RB + wc * 32 + 8 * fq; const unsigned ro0 = (unsigned)(u.pm * BM + wr * 64 + fr) * DM + ch0;
        f32x4 vba[2], vbx[2], vsp[2];
#pragma unroll
        for (int n = 0; n < 2; ++n) { vba[n] = *(const f32x4*)(ba + ch0 + 4 * n); vbx[n] = *(const f32x4*)(bx + ch0 + 4 * n); const f32x4 l = *(const f32x4*)(lam + ch0 + 4 * n);
#pragma unroll
            for (int e = 0; e < 4; ++e) { const float z = -l[e]; vsp[n][e] = -8.0f * ((z > 20.f) ? z : log1pf(__expf(z))); } }
#pragma unroll
        for (int ai = 0; ai < 2; ++ai)
#pragma unroll
            for (int m = 0; m < 4; ++m) { unsigned ro = ro0 + (unsigned)((ai * HALF + m * 16) * DM); asm volatile("" : "+v"(ro));
                const u32x4 ucw = *(const u32x4*)(UC + ro); const float uc[8] = {bf_lo(ucw.x), bf_hi(ucw.x), bf_lo(ucw.y), bf_hi(ucw.y), bf_lo(ucw.z), bf_hi(ucw.z), bf_lo(ucw.w), bf_hi(ucw.w)};
                float la[8], bv[8];
#pragma unroll
                for (int n = 0; n < 2; ++n)
#pragma unroll
                    for (int e = 0; e < 4; ++e) { const float r = sigmoidf_(acc[ai][0][m][n][e] + vba[n][e]), ig = sigmoidf_(acc[ai][1][m][n][e] + vbx[n][e]);
                        const float l_ = r * vsp[n][e], em = 2.0f * l_;
                        const float om = (em > -0.02f) ? -em * (1.0f + em * (0.5f + em * 0.16666667f)) : 1.0f - __expf(em);
                        la[4 * n + e] = l_; bv[4 * n + e] = __builtin_amdgcn_sqrtf(om) * (ig * uc[4 * n + e]); }
                u32x4 w; w.x = cvt_pk_bf16(la[0], la[1]); w.y = cvt_pk_bf16(la[2], la[3]); w.z = cvt_pk_bf16(la[4], la[5]); w.w = cvt_pk_bf16(la[6], la[7]); *(u32x4*)(LA + ro) = w;
                w.x = cvt_pk_bf16(bv[0], bv[1]); w.y = cvt_pk_bf16(bv[2], bv[3]); w.z = cvt_pk_bf16(bv[4], bv[5]); w.w = cvt_pk_bf16(bv[6], bv[7]); *(u32x4*)(BV + ro) = w;
                if (m & 1) asm volatile("" ::: "memory"); }
    }
};

template <class Epi, class Sched, bool ALIGN_EPI = false, bool SP2 = false>
__device__ __forceinline__ void gemm_phase(PG8_LAS unsigned char* lds, const Gemm g, const Sched& S, const Epi& E) {
    const int tid = threadIdx.x, wid = __builtin_amdgcn_readfirstlane(tid >> 6), lane = tid & 63, wr = wid >> 2, wc = wid & 3, fr = lane & 15, fq = lane >> 4;
    int K = g.K; asm volatile("" : "+s"(K)); const int nt = K / BK;
    unsigned voffA[2], voffB[2];
#pragma unroll
    for (int i = 0; i < 2; ++i) { int R, C; stage_rc(tid * 16 + i * 8192, R, C); const int Rb = Epi::PERM ? ((R & ~31) + perm32(R & 31)) : R;
        voffA[i] = (unsigned)(R * g.lda + C) * 2u; voffB[i] = (unsigned)(Rb * g.ldb + C) * 2u; }
    const size_t kstep = (size_t)(BK * 2);
    const size_t hstepA = (size_t)HALF * g.lda * 2, hstepB = (size_t)HALF * g.ldb * 2;
    const unsigned ldsw = (unsigned)wid * 1024u;
    const int aoff = lds_byte(wr * 64 + fr, fq * 8), boff = lds_byte(wc * 32 + fr, fq * 8);
#define PG8_SA(b, h) (((b) * 2 + (h)) * HTB)
#define PG8_SB(b, h) ((4 + (b) * 2 + (h)) * HTB)
#define PG8_STAGE(bufoff, gbase, voff) do { _Pragma("unroll") for (int _i = 0; _i < 2; ++_i) \
        __builtin_amdgcn_global_load_lds((const unsigned*)((const char*)(gbase) + (voff)[_i]), (PG8_LAS unsigned*)(lds + (bufoff) + ldsw + _i * 8192), 16, 0, 0); } while (0)
#define PG8_LDA(dst, b, h) do { _Pragma("unroll") for (int m = 0; m < 4; ++m) _Pragma("unroll") for (int k = 0; k < 2; ++k) dst[m][k] = *(const PG8_LAS bf16x8*)(lds + PG8_SA(b, h) + aoff + m * 2048 + k * 1024); } while (0)
#define PG8_LDB(dst, b, h) do { _Pragma("unroll") for (int n = 0; n < 2; ++n) _Pragma("unroll") for (int k = 0; k < 2; ++k) dst[n][k] = *(const PG8_LAS bf16x8*)(lds + PG8_SB(b, h) + boff + n * 2048 + k * 1024); } while (0)
#define PG8_MMA(ai, bj, At, Bt) do { __builtin_amdgcn_s_setprio(1); _Pragma("unroll") for (int m = 0; m < 4; ++m) _Pragma("unroll") for (int n = 0; n < 2; ++n) _Pragma("unroll") for (int k = 0; k < 2; ++k) \
        acc[ai][bj][m][n] = __builtin_amdgcn_mfma_f32_16x16x32_bf16(Bt[n][k], At[m][k], acc[ai][bj][m][n], 0, 0, 0); __builtin_amdgcn_s_setprio(0); } while (0)
#define PG8_WAIT_V(n) asm volatile("s_waitcnt vmcnt(" #n ")" ::: "memory")
#define PG8_WAIT_L(n) asm volatile("s_waitcnt lgkmcnt(" #n ")" ::: "memory")
#define PG8_BAR __builtin_amdgcn_s_barrier()
#define PG8_SCHED __builtin_amdgcn_sched_barrier(0)
    Unit cur, nxt; int ui = 0;
    if (!S.next(0, cur)) return;
    f32x4 acc[2][2][4][2];
#pragma unroll
    for (int a = 0; a < 2; ++a)
#pragma unroll
        for (int b = 0; b < 2; ++b)
#pragma unroll
            for (int m = 0; m < 4; ++m)
#pragma unroll
                for (int n = 0; n < 2; ++n) acc[a][b][m][n] = (f32x4){0.f, 0.f, 0.f, 0.f};
    bf16x8 At[4][2], B0[2][2], B1[2][2];
    const char* cA = g.a_ptr(cur); const char* cB = g.b_ptr(cur); const char* cA3 = g.ksplit ? g.a3_ptr(cur) : cA;
    S.a_ready(cur);
    if constexpr (SP2) {
        PG8_STAGE(PG8_SB(0, 0), cB, voffB); PG8_STAGE(PG8_SB(0, 1), cB + hstepB, voffB); PG8_STAGE(PG8_SA(0, 0), cA, voffA); PG8_STAGE(PG8_SA(0, 1), cA + hstepA, voffA);
        if (wr == 1) PG8_BAR;
        PG8_WAIT_V(2); PG8_BAR;
        PG8_STAGE(PG8_SB(1, 0), cB + kstep, voffB); PG8_STAGE(PG8_SA(1, 0), cA + kstep, voffA); PG8_STAGE(PG8_SB(1, 1), cB + hstepB + kstep, voffB);
        PG8_WAIT_V(6); PG8_BAR;
    } else {
        PG8_STAGE(PG8_SB(0, 0), cB, voffB); PG8_STAGE(PG8_SA(0, 0), cA, voffA); PG8_STAGE(PG8_SB(0, 1), cB + hstepB, voffB); PG8_STAGE(PG8_SA(0, 1), cA + hstepA, voffA);
        if (wr == 1) PG8_BAR;
        PG8_WAIT_V(4); PG8_BAR;
        PG8_STAGE(PG8_SB(1, 0), cB + kstep, voffB); PG8_STAGE(PG8_SA(1, 0), cA + kstep, voffA); PG8_STAGE(PG8_SB(1, 1), cB + hstepB + kstep, voffB);
        PG8_WAIT_V(6); PG8_BAR;
    }
    for (;;) {
        const bool has_next = S.next(ui + 1, nxt);
        const char* nA = has_next ? g.a_ptr(nxt) : cA; const char* nB = has_next ? g.b_ptr(nxt) : cB;
        for (int t = 0; t < nt; t += 2) {
            const bool last = (t == nt - 2);
            if constexpr (Epi::HAS_MID) { if (t == g.ksplit) E.mid(acc, cur, wr, wc, fr, fq); }
            const char* a1 = ((g.ksplit && t + 1 >= g.ksplit) ? cA3 : cA) + (size_t)(t + 1) * kstep;
            const char* a2 = last ? nA : ((g.ksplit && t + 2 >= g.ksplit) ? cA3 : cA) + (size_t)(t + 2) * kstep; const char* b2 = last ? nB : cB + (size_t)(t + 2) * kstep;
            const char* a3 = a2 + kstep; const char* b3 = b2 + kstep;
            if (last && has_next) S.a_ready(nxt);
            if constexpr (SP2) {
            PG8_LDB(B0, 0, 0); PG8_LDB(B1, 0, 1); PG8_SCHED; PG8_LDA(At, 0, 0); PG8_STAGE(PG8_SA(1, 1), a1 + hstepA, voffA);
            PG8_WAIT_V(8); PG8_WAIT_L(0); PG8_BAR; PG8_MMA(0, 0, At, B0); PG8_MMA(0, 1, At, B1); PG8_BAR; PG8_SCHED;
            PG8_LDA(At, 0, 1); PG8_STAGE(PG8_SB(0, 0), b2, voffB); PG8_STAGE(PG8_SB(0, 1), b2 + hstepB, voffB); PG8_STAGE(PG8_SA(0, 0), a2, voffA);
            PG8_WAIT_V(8); PG8_WAIT_L(0); PG8_BAR; PG8_MMA(1, 0, At, B0); PG8_MMA(1, 1, At, B1); PG8_BAR; PG8_SCHED;
            PG8_LDB(B0, 1, 0); PG8_LDB(B1, 1, 1); PG8_SCHED; PG8_LDA(At, 1, 0); PG8_STAGE(PG8_SA(0, 1), a2 + hstepA, voffA);
            PG8_WAIT_V(8); PG8_WAIT_L(0); PG8_BAR; PG8_MMA(0, 0, At, B0); PG8_MMA(0, 1, At, B1); PG8_BAR; PG8_SCHED;
            PG8_LDA(At, 1, 1); PG8_STAGE(PG8_SB(1, 0), b3, voffB); PG8_STAGE(PG8_SB(1, 1), b3 + hstepB, voffB); PG8_STAGE(PG8_SA(1, 0), a3, voffA);
            PG8_WAIT_V(8); PG8_WAIT_L(0); PG8_BAR; PG8_MMA(1, 0, At, B0); PG8_MMA(1, 1, At, B1); PG8_BAR; PG8_SCHED;
            } else {
            PG8_LDB(B0, 0, 0); PG8_SCHED; PG8_LDA(At, 0, 0); PG8_STAGE(PG8_SA(1, 1), a1 + hstepA, voffA);
            PG8_WAIT_L(8); PG8_BAR; PG8_WAIT_L(0); PG8_MMA(0, 0, At, B0); PG8_BAR; PG8_SCHED;
            PG8_LDB(B1, 0, 1); PG8_STAGE(PG8_SB(0, 0), b2, voffB);
            PG8_BAR; PG8_WAIT_L(0); PG8_MMA(0, 1, At, B1); PG8_BAR;
            PG8_LDA(At, 0, 1); PG8_STAGE(PG8_SA(0, 0), a2, voffA);
            PG8_BAR; PG8_WAIT_L(0); PG8_MMA(1, 0, At, B0); PG8_BAR; PG8_SCHED;
            PG8_STAGE(PG8_SB(0, 1), b2 + hstepB, voffB);
            PG8_WAIT_V(6); PG8_BAR; PG8_MMA(1, 1, At, B1); PG8_BAR;
            PG8_LDB(B0, 1, 0); PG8_SCHED; PG8_LDA(At, 1, 0); PG8_STAGE(PG8_SA(0, 1), a2 + hstepA, voffA);
            PG8_WAIT_L(8); PG8_BAR; PG8_WAIT_L(0); PG8_MMA(0, 0, At, B0); PG8_BAR; PG8_SCHED;
            PG8_LDB(B1, 1, 1); PG8_STAGE(PG8_SB(1, 0), b3, voffB);
            PG8_BAR; PG8_WAIT_L(0); PG8_MMA(0, 1, At, B1); PG8_BAR;
            PG8_LDA(At, 1, 1); PG8_STAGE(PG8_SA(1, 0), a3, voffA);
            PG8_BAR; PG8_WAIT_L(0); PG8_MMA(1, 0, At, B0); PG8_BAR; PG8_SCHED;
            PG8_STAGE(PG8_SB(1, 1), b3 + hstepB, voffB);
            PG8_WAIT_V(6); PG8_BAR; PG8_MMA(1, 1, At, B1); PG8_BAR;
            }
        }
        if constexpr (ALIGN_EPI) { if (wr == 0) PG8_BAR; }
        if constexpr (!Epi::AFTER_DRAIN) { E(acc, cur, wr, wc, fr, fq); S.done(cur); }
        if (!has_next) break;
#pragma unroll
        for (int a = 0; a < 2; ++a)
#pragma unroll
            for (int b = 0; b < 2; ++b)
#pragma unroll
                for (int m = 0; m < 4; ++m)
#pragma unroll
                    for (int n = 0; n < 2; ++n) acc[a][b][m][n] = (f32x4){0.f, 0.f, 0.f, 0.f};
        cur = nxt; cA = nA; cB = nB; cA3 = g.ksplit ? g.a3_ptr(cur) : cA; ++ui;
        if constexpr (ALIGN_EPI) { if (wr == 1) PG8_BAR; }
    }
    PG8_WAIT_V(0);
    if constexpr (!ALIGN_EPI) { if (wr == 0) PG8_BAR; }
    PG8_BAR;
    if constexpr (Epi::AFTER_DRAIN) { E.fused(acc, cur, wr, wc, fr, fq, lds, wid, lane); S.done(cur); }
#undef PG8_SA
#undef PG8_SB
#undef PG8_STAGE
#undef PG8_LDA
#undef PG8_LDB
#undef PG8_MMA
#undef PG8_WAIT_V
#undef PG8_WAIT_L
#undef PG8_BAR
#undef PG8_SCHED
}
}

#define XB_TMO      128
#define XB_XCNT(j)  (256  + 64 * (j))
#define XB_XSUB(j)  (1280 + 64 * (j))
#define XB_XGEN(j)  (2304 + 64 * (j))
#define XB_TOP      3328
#define XB_TOPGEN   3392
#define XCD_BAR_WORDS 3456
#define XB_SPIN_CAP (1u << 18)

__device__ __forceinline__ unsigned xb_ld(unsigned* p)              { return __hip_atomic_load(p, __ATOMIC_RELAXED, __HIP_MEMORY_SCOPE_AGENT); }
__device__ __forceinline__ unsigned xb_add(unsigned* p, unsigned v) { return __hip_atomic_fetch_add(p, v, __ATOMIC_RELAXED, __HIP_MEMORY_SCOPE_AGENT); }
__device__ __forceinline__ unsigned xb_xcc_id() { return (unsigned)__builtin_amdgcn_s_getreg((3 << 11) | 20) & 0xFu; }
#define XB_SPIN(cond, bar) do { unsigned _sp = 0; while (cond) { __builtin_amdgcn_s_sleep(1); \
    if ((++_sp & 255u) == 0u) { if (xb_ld(&(bar)[XB_TMO])) break; if (_sp > XB_SPIN_CAP) { atomicAdd(&(bar)[XB_TMO], 1u); break; } } } } while (0)

struct XcdBarrier {
    unsigned* bar; unsigned x;
    volatile LAS unsigned* st;
};

__device__ __forceinline__ XcdBarrier xcd_barrier_post(unsigned* bar, volatile LAS unsigned* st) {
    XcdBarrier b; b.bar = bar; b.x = xb_xcc_id(); b.st = st;
    if (threadIdx.x == 0) (void)xb_add(&bar[XB_XCNT(b.x)], 1u);
    return b;
}
__device__ __forceinline__ void xcd_barrier_complete(unsigned* bar, unsigned x, unsigned& nloc, unsigned& nx) {
    const unsigned G = gridDim.x * gridDim.y * gridDim.z;
    unsigned sum, cnt, mine, sp = 0u;
    for (;;) {
        sum = 0u; cnt = 0u; mine = 0u;
#pragma unroll
        for (unsigned j = 0; j < 16; ++j) { const unsigned c = xb_ld(&bar[XB_XCNT(j)]); sum += c; cnt += (c > 0u) ? 1u : 0u; mine = (j == x) ? c : mine; }
        if (sum == G) break;
        __builtin_amdgcn_s_sleep(1);
        if ((++sp & 255u) == 0u) { if (xb_ld(&bar[XB_TMO])) break; if (sp > XB_SPIN_CAP) { atomicAdd(&bar[XB_TMO], 1u); break; } }
    }
    nloc = mine > 0u ? mine : 1u; nx = cnt > 0u ? cnt : 1u;
}

__device__ __forceinline__ void xcd_barrier(const XcdBarrier& b) {
    asm volatile("s_waitcnt vmcnt(0)" ::: "memory");
    __syncthreads();
    if (threadIdx.x == 0) {
        unsigned* bar = b.bar;
        __builtin_amdgcn_s_waitcnt(0);
        unsigned nloc = b.st[0], nx = b.st[1];
        if (nloc == 0u) { xcd_barrier_complete(bar, b.x, nloc, nx); b.st[0] = nloc; b.st[1] = nx; }
        const unsigned old = xb_add(&bar[XB_XSUB(b.x)], 1u);
        const unsigned gen = old / nloc;
        if (old + 1u == (gen + 1u) * nloc) {
            __builtin_amdgcn_fence(__ATOMIC_RELEASE, "agent");
            asm volatile("s_waitcnt vmcnt(0)" ::: "memory");
            const unsigned og = xb_add(&bar[XB_TOP], 1u);
            const unsigned tg = og / nx;
            if (og + 1u == (tg + 1u) * nx) xb_add(&bar[XB_TOPGEN], 1u);
            else XB_SPIN(xb_ld(&bar[XB_TOPGEN]) == tg, bar);
            __builtin_amdgcn_fence(__ATOMIC_ACQUIRE, "agent");
            xb_add(&bar[XB_XGEN(b.x)], 1u);
            asm volatile("s_waitcnt vmcnt(0)" ::: "memory");
        } else {
            XB_SPIN(xb_ld(&bar[XB_XGEN(b.x)]) == gen, bar);
            __builtin_amdgcn_fence(__ATOMIC_ACQUIRE, "agent");
            asm volatile("s_waitcnt vmcnt(0)" ::: "memory");
        }
    }
    __syncthreads();
}

constexpr int NWAVES = 8, NTHR = NWAVES * 64;
constexpr int LDS_BYTES = 147456;
#define LDS_WAIT() asm volatile("s_waitcnt lgkmcnt(0)" ::: "memory")

struct Args {
    const float* in[28]; float* out; unsigned char* ws; int ph_lo, ph_hi;
};
enum { I_XP = 0, I_XS, I_SRC, I_SRH, I_CK, I_CV, I_SFC, I_NMG, I_WIN, I_BG, I_RCW, I_RCB, I_GAW, I_GAB, I_GXW, I_GXB, I_LAM, I_QG, I_KG, I_SINK, I_WRP, I_WAP, I_WOUT, I_NFG, I_WUP, I_FCW, I_FCB, I_WDN };

__device__ __forceinline__ float wave_sum(float v) {
#pragma unroll
    for (int o = 1; o < 64; o <<= 1) v += __shfl_xor(v, o);
    return v;
}
template <bool UPMAP = false> __device__ __forceinline__ void p0_transpose_item(const float* W, int K, int N, bf16_t* WT, int row_off, const float* ks, LAS float* scr, int item, int lane, int ldw = 0, int koff = 0) {
    const int nblk = N / 32, kb = item / nblk, nb = item % nblk, k0 = 64 * kb, n0 = 32 * nb;
#pragma unroll 8
    for (int i = 0; i < 32; ++i) { const int kk = 2 * i + (lane >> 5); float v = W[(size_t)(k0 + kk) * N + n0 + (lane & 31)]; if (ks) v *= ks[k0 + kk]; scr[kk * 33 + (lane & 31)] = v; }
    LDS_WAIT(); asm volatile("" ::: "memory");
    const int c = lane & 7;
#pragma unroll
    for (int j = 0; j < 4; ++j) { const int n = (lane >> 3) + 8 * j; const LAS float* s = scr + (8 * c) * 33 + n;
        u32x4 o; o.x = cvt_pk_bf16(s[0 * 33], s[1 * 33]); o.y = cvt_pk_bf16(s[2 * 33], s[3 * 33]); o.z = cvt_pk_bf16(s[4 * 33], s[5 * 33]); o.w = cvt_pk_bf16(s[6 * 33], s[7 * 33]);
        int orow = row_off + n0 + n;
        if (UPMAP) { const int nn = n0 + n, hf = nn >= DFF ? 1 : 0, jj = nn - hf * DFF; orow = (jj >> 7) * 256 + hf * 128 + (jj & 127); }
        *(u32x4*)(WT + (size_t)orow * (ldw ? ldw : K) + koff + k0 + 8 * c) = o; }
    LDS_WAIT(); asm volatile("" ::: "memory");
}

__device__ __forceinline__ void p0_prologue(const Args& a, LAS unsigned char* lds, int G, bool late) {
    const int tid = threadIdx.x, lane = tid & 63, wave = tid >> 6;
    LAS float* scr = (LAS float*)(lds + wave * 16384);
    const int skip = (late && G > 32) ? 16 : 0;
    if ((int)blockIdx.x < skip) return;
    const int gw = ((int)blockIdx.x - skip) * NWAVES + wave, NGW = (G - skip) * NWAVES;
    unsigned char* ws = a.ws;
    constexpr int T_IN = 16 * (INW / 32), T_SQ = 16 * 32, T_UP = 16 * (UPW / 32), T_DN = (DFF / 64) * 32, T_G = 16 * 8;
    constexpr int NITEMS = T_IN + 3 * T_SQ + T_UP + T_DN + T_G;
    for (int it = (late ? T_IN + T_G : 0) + gw; it < (late ? NITEMS : T_IN + T_G); it += NGW) {
        int r = it;
        if (r < T_IN) { p0_transpose_item(a.in[I_WIN], DM, INW, (bf16_t*)(ws + WS_WIN), 0, nullptr, scr, r, lane); continue; } r -= T_IN;
        if (r < T_G) { const int mat = r >> 3, sub = r & 7, blk = mat >> 1, which = mat & 1;
          p0_transpose_item(a.in[which ? I_GXW : I_GAW] + (size_t)blk * RB * RB, RB, RB, (bf16_t*)(ws + WS_WG) + (size_t)blk * 256 * RB, which * RB, nullptr, scr, sub, lane); continue; } r -= T_G;
        if (r < T_SQ) { p0_transpose_item(a.in[I_WRP], DM, DM, (bf16_t*)(ws + WS_WMIX), 0, nullptr, scr, r, lane, 2048, 0); continue; } r -= T_SQ;
        if (r < T_SQ) { p0_transpose_item(a.in[I_WAP], DM, DM, (bf16_t*)(ws + WS_WMIX), 0, nullptr, scr, r, lane, 2048, 1024); continue; } r -= T_SQ;
        if (r < T_SQ) { p0_transpose_item(a.in[I_WOUT], DM, DM, (bf16_t*)(ws + WS_WOUT), 0, nullptr, scr, r, lane); continue; } r -= T_SQ;
        if (r < T_UP) { p0_transpose_item<true>(a.in[I_WUP], DM, UPW, (bf16_t*)(ws + WS_WUP), 0, a.in[I_NFG], scr, r, lane); continue; } r -= T_UP;
        p0_transpose_item(a.in[I_WDN], DFF, DM, (bf16_t*)(ws + WS_WDN), 0, nullptr, scr, r, lane);
    }
    if (late) return;
    const float* g = a.in[I_NMG];
    f32x4 gv[4];
#pragma unroll
    for (int j = 0; j < 4; ++j) gv[j] = *((const f32x4*)g + lane + 64 * j);
    bf16_t* XB = (bf16_t*)(ws + WS_XB);
    for (int m0 = gw; m0 < MTOT; m0 += 4 * NGW) {
        f32x4 v[4][4];
#pragma unroll
        for (int r = 0; r < 4; ++r) { const int m = m0 + r * NGW; if (m < MTOT) {
            const float* xrow = (m < MP) ? a.in[I_XP] + (size_t)m * DM : a.in[I_XS] + (size_t)(m - MP) * DM; const f32x4* xr = (const f32x4*)xrow + lane;
#pragma unroll
            for (int j = 0; j < 4; ++j) v[r][j] = __builtin_nontemporal_load(xr + 64 * j); } }
#pragma unroll
        for (int r = 0; r < 4; ++r) { const int m = m0 + r * NGW; if (m < MTOT) {
            float s = 0.f;
#pragma unroll
            for (int j = 0; j < 4; ++j) s += (v[r][j].x * v[r][j].x + v[r][j].y * v[r][j].y) + (v[r][j].z * v[r][j].z + v[r][j].w * v[r][j].w);
            const float rs = rsqrtf(wave_sum(s) * (1.f / DM) + EPS);
            u32x2* o8 = (u32x2*)(XB + (size_t)m * DM) + lane;
#pragma unroll
            for (int j = 0; j < 4; ++j) { const f32x4 t = v[r][j] * rs * gv[j]; u32x2 w; w.x = cvt_pk_bf16(t.x, t.y); w.y = cvt_pk_bf16(t.z, t.w); o8[64 * j] = w; } } }
    }
    float* rss2 = (float*)(ws + WS_RSS2);
    for (int i = blockIdx.x * NTHR + tid; i < MTOT; i += G * NTHR) rss2[i] = 0.f;
}

__device__ __forceinline__ void conv_fix(const Args& a, int G) {
    bf16_t* UC = (bf16_t*)(a.ws + WS_UC);
    const float* HALOU = (const float*)(a.ws + WS_HALOU); const float* FIXU = (const float*)(a.ws + WS_FIXU);
    const float* cw = a.in[I_RCW]; const float* cb = a.in[I_RCB];
    constexpr int NG4 = DM / 4, NGRP = MP / 64;
    for (int it = blockIdx.x * NTHR + threadIdx.x; it < NGRP * NG4; it += G * NTHR) {
        const int g = it / NG4, c = (it - g * NG4) * 4;
        if ((g & (SEQ / 64 - 1)) == 0) continue;
        const f32x4 w0 = *(const f32x4*)(cw + c), w1 = *(const f32x4*)(cw + DM + c), w2 = *(const f32x4*)(cw + 2 * DM + c), w3 = *(const f32x4*)(cw + 3 * DM + c), bias = *(const f32x4*)(cb + c);
        f32x4 x[6];
#pragma unroll
        for (int k = 0; k < 3; ++k) { x[k] = *(const f32x4*)(HALOU + ((size_t)(g - 1) * 3 + k) * DM + c); x[3 + k] = *(const f32x4*)(FIXU + ((size_t)g * 3 + k) * DM + c); }
#pragma unroll
        for (int k = 0; k < 3; ++k) { const f32x4 y = x[k] * w0 + x[k + 1] * w1 + x[k + 2] * w2 + x[k + 3] * w3 + bias;
            u32x2 w; w.x = cvt_pk_bf16(y[0], y[1]); w.y = cvt_pk_bf16(y[2], y[3]); *(u32x2*)(UC + (size_t)(g * 64 + k) * DM + c) = w; }
    }
}

constexpr int KS_STRIDE = 272, VT_STRIDE = 392;
constexpr int KS_OFF = 0, VT_OFF = 192 * KS_STRIDE;
static_assert(VT_OFF + 128 * VT_STRIDE <= 131072, "attention LDS");

__device__ __forceinline__ void attn_phase(const Args& a, LAS unsigned char* lds, int G) {
    const int tid = threadIdx.x, lane = tid & 63, wave = __builtin_amdgcn_readfirstlane(tid >> 6), fr = lane & 15, fq = lane >> 4;
    const bf16_t* Q = (const bf16_t*)(a.ws + WS_Q); const bf16_t* KV = (const bf16_t*)(a.ws + WS_KV); bf16_t* YA = (bf16_t*)(a.ws + WS_YA);
    const float* qg = a.in[I_QG]; const float* kg = a.in[I_KG]; const float* sinks = a.in[I_SINK];
    constexpr int NPI = NBATCH * NCH * NKV;
    constexpr int NIT = NPI + SBATCH * NKV;
    const int vbid = (G % 8 == 0) ? (int)(blockIdx.x % 8) * (G / 8) + (int)(blockIdx.x / 8) : (int)blockIdx.x;
    for (int item = vbid; item < NIT; item += G) {
        const bool samp = item >= NPI;
        int b, c, kvh, kstart, nkeys, kpos0; long rowbase;
        if (!samp) { kvh = item & 1; c = (item >> 1) & (NCH - 1); b = item >> 8; kstart = (c >= 2) ? 0 : (2 - c) * 64; nkeys = 192; kpos0 = (c - 2) * 64; rowbase = (long)b * SEQ + (long)(c - 2) * 64; }
        else { const int si = item - NPI; kvh = si & 1; b = si >> 1; c = 0; kstart = 0; nkeys = 160; kpos0 = PAST - WIN; rowbase = (long)MP + b * SSEQ - 128; }
        const int hl = samp ? wave : (wave >> 1), th = samp ? 0 : (wave & 1), h = kvh * GRP + hl;
        const bool active = !samp || wave < 4;
        u32x4 qraw[2][4];
        const long qr0 = samp ? ((long)MP + b * SSEQ + fr) : ((long)b * SEQ + c * 64 + 32 * th + fr);
#pragma unroll
        for (int ks = 0; ks < 4; ++ks) qraw[0][ks] = active ? *(const u32x4*)(Q + (size_t)qr0 * DM + h * HD + 32 * ks + 8 * fq) : (u32x4){0u, 0u, 0u, 0u};
#pragma unroll
        for (int ks = 0; ks < 4; ++ks) qraw[1][ks] = (active && !samp) ? *(const u32x4*)(Q + (size_t)(qr0 + 16) * DM + h * HD + 32 * ks + 8 * fq) : (u32x4){0u, 0u, 0u, 0u};
        __syncthreads();
        if (!samp) {
            u32x4 kraw[6], vraw[6];
#pragma unroll
            for (int i = 0; i < 6; ++i) { const int ci = tid + i * NTHR, key = ci >> 4, d0 = (ci & 15) * 8;
                if (key >= kstart) { const bf16_t* rp = KV + (size_t)(rowbase + key) * 512 + kvh * HD + d0; kraw[i] = *(const u32x4*)rp; vraw[i] = *(const u32x4*)(rp + 256); }
                else { kraw[i] = (u32x4){0u, 0u, 0u, 0u}; vraw[i] = kraw[i]; } }
            const int d0 = (tid & 15) * 8;
            float kgv[8];
#pragma unroll
            for (int e = 0; e < 8; ++e) kgv[e] = kg[d0 + e];
#pragma unroll
            for (int i = 0; i < 6; ++i) {
                const int key = (tid >> 4) + i * 32; const bool valid = key >= kstart;
                const u32x4 kw = kraw[i], vw = vraw[i];
                float kv[8] = {bf_lo(kw.x), bf_hi(kw.x), bf_lo(kw.y), bf_hi(kw.y), bf_lo(kw.z), bf_hi(kw.z), bf_lo(kw.w), bf_hi(kw.w)};
                float ss = 0.f;
#pragma unroll
                for (int e = 0; e < 8; ++e) ss += kv[e] * kv[e];
                ss += __shfl_xor(ss, 1); ss += __shfl_xor(ss, 2); ss += __shfl_xor(ss, 4); ss += __shfl_xor(ss, 8);
                const float rs = valid ? rsqrtf(ss * (1.f / HD) + EPS) : 0.f;
#pragma unroll
                for (int e = 0; e < 8; ++e) kv[e] = kv[e] * rs * kgv[e];
                u32x4 w; w.x = cvt_pk_bf16(kv[0], kv[1]); w.y = cvt_pk_bf16(kv[2], kv[3]); w.z = cvt_pk_bf16(kv[4], kv[5]); w.w = cvt_pk_bf16(kv[6], kv[7]);
                *(LAS u32x4*)(lds + KS_OFF + key * KS_STRIDE + d0 * 2) = w;
                const unsigned vq[4] = {vw.x, vw.y, vw.z, vw.w};
#pragma unroll
                for (int e = 0; e < 8; ++e) *(LAS bf16_t*)(lds + VT_OFF + (d0 + e) * VT_STRIDE + (key ^ (((d0 >> 3) & 7) << 2)) * 2) = (bf16_t)((e & 1) ? (vq[e >> 1] >> 16) : (vq[e >> 1] & 0xffffu));
                if (c >= NCH - 2 && key >= 128) { const size_t o = (((size_t)b * WIN + (size_t)(c - (NCH - 2)) * 64 + (key - 128)) * NKV + kvh) * HD + d0;
                    *(f32x4*)(a.out + O_KP + o) = (f32x4){kv[0], kv[1], kv[2], kv[3]}; *(f32x4*)(a.out + O_KP + o + 4) = (f32x4){kv[4], kv[5], kv[6], kv[7]};
                    *(f32x4*)(a.out + O_VP + o) = (f32x4){bf_lo(vw.x), bf_hi(vw.x), bf_lo(vw.y), bf_hi(vw.y)}; *(f32x4*)(a.out + O_VP + o + 4) = (f32x4){bf_lo(vw.z), bf_hi(vw.z), bf_lo(vw.w), bf_hi(vw.w)}; }
                asm volatile("" ::: "memory");
            }
        } else {
#pragma unroll
        for (int ii = 0; ii < 5; ++ii) { const int ci = tid + ii * NTHR;
            const int key = ci >> 4, d0 = (ci & 15) * 8;
            float kv[8], vv[8]; bool valid = key < 144, donorm = true;
            if (valid) {
                if (key < 128) { donorm = false;
                    const float* kp = a.in[I_CK] + (((size_t)b * WIN + key) * NKV + kvh) * HD + d0; const float* vp = a.in[I_CV] + (((size_t)b * WIN + key) * NKV + kvh) * HD + d0;
                    const f32x4 k0 = *(const f32x4*)kp, k1 = *(const f32x4*)(kp + 4), v0 = *(const f32x4*)vp, v1 = *(const f32x4*)(vp + 4);
#pragma unroll
                    for (int e = 0; e < 4; ++e) { kv[e] = k0[e]; kv[4 + e] = k1[e]; vv[e] = v0[e]; vv[4 + e] = v1[e]; }
                } else {
                    const bf16_t* rp = KV + (size_t)(rowbase + key) * 512 + kvh * HD + d0;
                    const u32x4 kw = *(const u32x4*)rp, vw = *(const u32x4*)(rp + 256);
                    kv[0] = bf_lo(kw.x); kv[1] = bf_hi(kw.x); kv[2] = bf_lo(kw.y); kv[3] = bf_hi(kw.y); kv[4] = bf_lo(kw.z); kv[5] = bf_hi(kw.z); kv[6] = bf_lo(kw.w); kv[7] = bf_hi(kw.w);
                    vv[0] = bf_lo(vw.x); vv[1] = bf_hi(vw.x); vv[2] = bf_lo(vw.y); vv[3] = bf_hi(vw.y); vv[4] = bf_lo(vw.z); vv[5] = bf_hi(vw.z); vv[6] = bf_lo(vw.w); vv[7] = bf_hi(vw.w);
                }
            } else {
#pragma unroll
                for (int e = 0; e < 8; ++e) { kv[e] = 0.f; vv[e] = 0.f; }
            }
            float ss = 0.f;
#pragma unroll
            for (int e = 0; e < 8; ++e) ss += kv[e] * kv[e];
            ss += __shfl_xor(ss, 1); ss += __shfl_xor(ss, 2); ss += __shfl_xor(ss, 4); ss += __shfl_xor(ss, 8);
            if (valid && donorm) { const float rs = rsqrtf(ss * (1.f / HD) + EPS);
#pragma unroll
                for (int e = 0; e < 8; ++e) kv[e] = kv[e] * rs * kg[d0 + e]; }
            u32x4 w; w.x = cvt_pk_bf16(kv[0], kv[1]); w.y = cvt_pk_bf16(kv[2], kv[3]); w.z = cvt_pk_bf16(kv[4], kv[5]); w.w = cvt_pk_bf16(kv[6], kv[7]);
            *(LAS u32x4*)(lds + KS_OFF + key * KS_STRIDE + d0 * 2) = w;
            u32x4 vw2; vw2.x = cvt_pk_bf16(vv[0], vv[1]); vw2.y = cvt_pk_bf16(vv[2], vv[3]); vw2.z = cvt_pk_bf16(vv[4], vv[5]); vw2.w = cvt_pk_bf16(vv[6], vv[7]);
            const unsigned vq[4] = {vw2.x, vw2.y, vw2.z, vw2.w};
#pragma unroll
            for (int e = 0; e < 8; ++e) *(LAS bf16_t*)(lds + VT_OFF + (d0 + e) * VT_STRIDE + (key ^ (((d0 >> 3) & 7) << 2)) * 2) = (bf16_t)((e & 1) ? (vq[e >> 1] >> 16) : (vq[e >> 1] & 0xffffu));
            if (key >= 16 && key < 144) { const size_t o = (((size_t)b * WIN + (key - 16)) * NKV + kvh) * HD + d0;
                *(f32x4*)(a.out + O_KS + o) = (f32x4){kv[0], kv[1], kv[2], kv[3]}; *(f32x4*)(a.out + O_KS + o + 4) = (f32x4){kv[4], kv[5], kv[6], kv[7]};
                *(f32x4*)(a.out + O_VS + o) = (f32x4){vv[0], vv[1], vv[2], vv[3]}; *(f32x4*)(a.out + O_VS + o + 4) = (f32x4){vv[4], vv[5], vv[6], vv[7]}; }
        }
        }
        __syncthreads();
        if (active) {
            const float slope = exp2f(-(float)(h + 1)) * 1.4426950408889634f, sink = sinks[h] * 1.4426950408889634f;
            const int nt0 = kstart >> 4, ntile = nkeys >> 4;
            const long qrow0 = qr0; const int qpos0 = samp ? (PAST + fr) : (c * 64 + 32 * th + fr);
            bf16x8 qf[2][4];
#pragma unroll
            for (int mt = 0; mt < 2; ++mt) { float qv[4][8]; float ss = 0.f;
#pragma unroll
                for (int ks = 0; ks < 4; ++ks) { const u32x4 w = qraw[mt][ks];
                    qv[ks][0] = bf_lo(w.x); qv[ks][1] = bf_hi(w.x); qv[ks][2] = bf_lo(w.y); qv[ks][3] = bf_hi(w.y); qv[ks][4] = bf_lo(w.z); qv[ks][5] = bf_hi(w.z); qv[ks][6] = bf_lo(w.w); qv[ks][7] = bf_hi(w.w);
#pragma unroll
                    for (int e = 0; e < 8; ++e) ss += qv[ks][e] * qv[ks][e]; }
                ss += __shfl_xor(ss, 16); ss += __shfl_xor(ss, 32);
                const float rs = rsqrtf(ss * (1.f / HD) + EPS) * (0.08838834764831845f * 1.4426950408889634f);
#pragma unroll
                for (int ks = 0; ks < 4; ++ks) { const float* gp = qg + 32 * ks + 8 * fq; float t[8];
#pragma unroll
                    for (int e = 0; e < 8; ++e) t[e] = qv[ks][e] * rs * gp[e];
                    u32x4 w; w.x = cvt_pk_bf16(t[0], t[1]); w.y = cvt_pk_bf16(t[2], t[3]); w.z = cvt_pk_bf16(t[4], t[5]); w.w = cvt_pk_bf16(t[6], t[7]);
                    qf[mt][ks] = __builtin_bit_cast(bf16x8, w); } }
            f32x4 s[2][12]; float mx0 = -INFINITY, mx1 = -INFINITY; const float fb0 = (float)(qpos0 - kpos0 - 4 * fq), fb1 = fb0 + 16.f;
#pragma unroll
            for (int n = 0; n < 12; ++n) {
                s[0][n] = (f32x4){-INFINITY, -INFINITY, -INFINITY, -INFINITY}; s[1][n] = s[0][n];
                if (n >= nt0 && n < ntile) {
                    f32x4 a0 = (f32x4){0.f, 0.f, 0.f, 0.f}, a1 = a0;
#pragma unroll
                    for (int ks = 0; ks < 4; ++ks) { const bf16x8 kf = *(const LAS bf16x8*)(lds + KS_OFF + (16 * n + fr) * KS_STRIDE + (32 * ks + 8 * fq) * 2);
                        a0 = __builtin_amdgcn_mfma_f32_16x16x32_bf16(kf, qf[0][ks], a0, 0, 0, 0); a1 = __builtin_amdgcn_mfma_f32_16x16x32_bf16(kf, qf[1][ks], a1, 0, 0, 0); }
#pragma unroll
                    for (int e = 0; e < 4; ++e) { const float kc = (float)(16 * n + e); float v0 = fmaf(-slope, fabsf(fb0 - kc), a0[e]), v1 = fmaf(-slope, fabsf(fb1 - kc), a1[e]);
                        if (samp && 16 * n + 4 * fq + e >= 144) { v0 = -INFINITY; v1 = -INFINITY; } s[0][n][e] = v0; s[1][n][e] = v1; mx0 = fmaxf(mx0, v0); mx1 = fmaxf(mx1, v1); }
                }
                if ((n & 3) == 3) __builtin_amdgcn_sched_barrier(0);
            }
            mx0 = fmaxf(mx0, __shfl_xor(mx0, 16)); mx0 = fmaxf(mx0, __shfl_xor(mx0, 32)); mx0 = fmaxf(mx0, sink);
            mx1 = fmaxf(mx1, __shfl_xor(mx1, 16)); mx1 = fmaxf(mx1, __shfl_xor(mx1, 32)); mx1 = fmaxf(mx1, sink);
            float sum0 = 0.f, sum1 = 0.f;
#pragma unroll
            for (int n = 0; n < 12; ++n)
#pragma unroll
                for (int e = 0; e < 4; ++e) { const float p0 = __builtin_amdgcn_exp2f(s[0][n][e] - mx0), p1 = __builtin_amdgcn_exp2f(s[1][n][e] - mx1); s[0][n][e] = p0; s[1][n][e] = p1; sum0 += p0; sum1 += p1; }
            sum0 += __shfl_xor(sum0, 16); sum0 += __shfl_xor(sum0, 32); sum1 += __shfl_xor(sum1, 16); sum1 += __shfl_xor(sum1, 32);
            const float inv0 = __builtin_amdgcn_rcpf(sum0 + __builtin_amdgcn_exp2f(sink - mx0)), inv1 = __builtin_amdgcn_rcpf(sum1 + __builtin_amdgcn_exp2f(sink - mx1));
            bf16x8 pf[2][6];
#pragma unroll
            for (int mt = 0; mt < 2; ++mt)
#pragma unroll
                for (int j = 0; j < 6; ++j) { u32x4 w; w.x = cvt_pk_bf16(s[mt][2 * j][0], s[mt][2 * j][1]); w.y = cvt_pk_bf16(s[mt][2 * j][2], s[mt][2 * j][3]);
                    w.z = cvt_pk_bf16(s[mt][2 * j + 1][0], s[mt][2 * j + 1][1]); w.w = cvt_pk_bf16(s[mt][2 * j + 1][2], s[mt][2 * j + 1][3]); pf[mt][j] = __builtin_bit_cast(bf16x8, w); }
#pragma unroll
            for (int dt = 0; dt < 8; ++dt) {
                f32x4 a0 = (f32x4){0.f, 0.f, 0.f, 0.f}, a1 = a0;
#pragma unroll
                for (int j = 0; j < 6; ++j) { if (2 * j >= nt0 && 2 * j < ntile) {
                    const int vsw = ((2 * dt + (fr >> 3)) & 7) << 2;
                    const LAS unsigned char* vp = lds + VT_OFF + (16 * dt + fr) * VT_STRIDE + 64 * j;
                    const u32x2 lo = *(const LAS u32x2*)(vp + ((4 * fq) ^ vsw) * 2), hi = *(const LAS u32x2*)(vp + ((4 * fq + 16) ^ vsw) * 2);
                    u32x4 w; w.x = lo.x; w.y = lo.y; w.z = hi.x; w.w = hi.y; const bf16x8 vf = __builtin_bit_cast(bf16x8, w);
                    a0 = __builtin_amdgcn_mfma_f32_16x16x32_bf16(vf, pf[0][j], a0, 0, 0, 0); a1 = __builtin_amdgcn_mfma_f32_16x16x32_bf16(vf, pf[1][j], a1, 0, 0, 0); } }
                u32x2 w; w.x = cvt_pk_bf16(a0[0] * inv0, a0[1] * inv0); w.y = cvt_pk_bf16(a0[2] * inv0, a0[3] * inv0);
                *(u32x2*)(YA + (size_t)qrow0 * DM + h * HD + 16 * dt + 4 * fq) = w;
                if (!samp) { w.x = cvt_pk_bf16(a1[0] * inv1, a1[1] * inv1); w.y = cvt_pk_bf16(a1[2] * inv1, a1[3] * inv1); *(u32x2*)(YA + (size_t)(qrow0 + 16) * DM + h * HD + 16 * dt + 4 * fq) = w; }
                if (dt & 1) __builtin_amdgcn_sched_barrier(0);
            }
        }
    }
    __syncthreads();
}

__device__ __forceinline__ void scan_agg(const Args& a, int G) {
    const bf16_t* LA = (const bf16_t*)(a.out); const bf16_t* BV = LA + (size_t)MTOT * DM;
    float* CA = (float*)(a.ws + WS_CA); float* CB = (float*)(a.ws + WS_CB);
    const int ch = 2 * threadIdx.x;
    for (int q = blockIdx.x; q < MP / 64; q += G) {
        const unsigned* lp = (const unsigned*)(LA + (size_t)q * 64 * DM + ch); const unsigned* bp = (const unsigned*)(BV + (size_t)q * 64 * DM + ch);
        float s0 = 0.f, s1 = 0.f, h0 = 0.f, h1 = 0.f;
        unsigned lw[64], bw[64];
#pragma unroll
        for (int t = 0; t < 64; ++t) { lw[t] = lp[(size_t)t * (DM / 2)]; bw[t] = bp[(size_t)t * (DM / 2)]; }
#pragma unroll
        for (int t = 0; t < 64; ++t) { const float l0 = bf_lo(lw[t]), l1 = bf_hi(lw[t]); s0 += l0; s1 += l1; h0 = __expf(l0) * h0 + bf_lo(bw[t]); h1 = __expf(l1) * h1 + bf_hi(bw[t]); }
        *(f32x2*)(CA + (size_t)q * DM + ch) = (f32x2){s0, s1}; *(f32x2*)(CB + (size_t)q * DM + ch) = (f32x2){h0, h1};
    }
}
__device__ __forceinline__ void scan_carry(const Args& a, int G) {
    const float* CA = (const float*)(a.ws + WS_CA); const float* CB = (const float*)(a.ws + WS_CB); float* CR = (float*)(a.ws + WS_CARRY);
    for (int i = blockIdx.x * NTHR + threadIdx.x; i < NBATCH * DM; i += G * NTHR) {
        const int b = i >> 10, ch = i & 1023; float carry = 0.f;
#pragma unroll 32
        for (int c = 0; c < NCH; ++c) { const size_t o = (size_t)(b * NCH + c) * DM + ch; CR[o] = carry; carry = __expf(CA[o]) * carry + CB[o]; }
        a.out[O_HP + (size_t)b * DM + ch] = carry;
    }
}
__device__ __forceinline__ void scan_full(const Args& a, int G) {
    const bf16_t* LA = (const bf16_t*)(a.out); const bf16_t* BV = LA + (size_t)MTOT * DM;
    const float* CR = (const float*)(a.ws + WS_CARRY); bf16_t* YR = (bf16_t*)(a.ws + WS_YR);
    const int ch = 2 * threadIdx.x;
    for (int q = blockIdx.x; q < MP / 64 + SBATCH; q += G) {
        const bool samp = q >= MP / 64; const int sb = q - MP / 64;
        const size_t row0 = samp ? (size_t)MP + (size_t)sb * SSEQ : (size_t)q * 64; const int n = samp ? SSEQ : 64;
        const unsigned* lp = (const unsigned*)(LA + row0 * DM + ch); const unsigned* bp = (const unsigned*)(BV + row0 * DM + ch); unsigned* yp = (unsigned*)(YR + row0 * DM + ch);
        f32x2 h = samp ? *(const f32x2*)(a.in[I_SRH] + (size_t)sb * DM + ch) : *(const f32x2*)(CR + (size_t)q * DM + ch);
        if (!samp) {
            unsigned lw[64], bw[64];
#pragma unroll
            for (int t = 0; t < 64; ++t) { lw[t] = lp[(size_t)t * (DM / 2)]; bw[t] = bp[(size_t)t * (DM / 2)]; }
#pragma unroll
            for (int t = 0; t < 64; ++t) { h.x = __expf(bf_lo(lw[t])) * h.x + bf_lo(bw[t]); h.y = __expf(bf_hi(lw[t])) * h.y + bf_hi(bw[t]); yp[(size_t)t * (DM / 2)] = cvt_pk_bf16(h.x, h.y); }
        } else {
#pragma unroll
            for (int t = 0; t < SSEQ; ++t) { const unsigned lw = lp[(size_t)t * (DM / 2)], bw = bp[(size_t)t * (DM / 2)];
                h.x = __expf(bf_lo(lw)) * h.x + bf_lo(bw); h.y = __expf(bf_hi(lw)) * h.y + bf_hi(bw); yp[(size_t)t * (DM / 2)] = cvt_pk_bf16(h.x, h.y); }
        }
        if (samp) *(f32x2*)(a.out + O_HS + (size_t)sb * DM + ch) = h;
    }
}

__device__ __forceinline__ void ffn_fix(const Args& a, int G) {
    bf16_t* Gb = (bf16_t*)(a.ws + WS_G);
    const float* HALO = (const float*)(a.ws + WS_HALO); const float* FIXA = (const float*)(a.ws + WS_FIXA); const float* FIXB = (const float*)(a.ws + WS_FIXB);
    const float* cw = a.in[I_FCW]; const float* cb = a.in[I_FCB];
    constexpr int NG4 = DFF / 4, NGRP = MP / 64;
    for (int it = blockIdx.x * NTHR + threadIdx.x; it < NGRP * NG4; it += G * NTHR) {
        const int g = it / NG4, j = (it - g * NG4) * 4;
        if ((g & (SEQ / 64 - 1)) == 0) continue;
        const f32x4 w0 = *(const f32x4*)(cw + j), w1 = *(const f32x4*)(cw + DFF + j), w2 = *(const f32x4*)(cw + 2 * DFF + j), bias = *(const f32x4*)(cb + j);
        const f32x4 h0 = *(const f32x4*)(HALO + ((size_t)(g - 1) * 2 + 0) * DFF + j), h1 = *(const f32x4*)(HALO + ((size_t)(g - 1) * 2 + 1) * DFF + j);
        const f32x4 a0 = *(const f32x4*)(FIXA + ((size_t)g * 2 + 0) * DFF + j), a1 = *(const f32x4*)(FIXA + ((size_t)g * 2 + 1) * DFF + j);
        const f32x4 b0 = *(const f32x4*)(FIXB + ((size_t)g * 2 + 0) * DFF + j), b1 = *(const f32x4*)(FIXB + ((size_t)g * 2 + 1) * DFF + j);
        const f32x4 y0 = h0 * w0 + h1 * w1 + a0 * w2 + bias, y1 = h1 * w0 + a0 * w1 + a1 * w2 + bias; f32x4 g0, g1;
#pragma unroll
        for (int e = 0; e < 4; ++e) { g0[e] = gelu_f(y0[e]) * b0[e]; g1[e] = gelu_f(y1[e]) * b1[e]; }
        u32x2 w; w.x = cvt_pk_bf16(g0[0], g0[1]); w.y = cvt_pk_bf16(g0[2], g0[3]); *(u32x2*)(Gb + (size_t)(g * 64) * DFF + j) = w;
        w.x = cvt_pk_bf16(g1[0], g1[1]); w.y = cvt_pk_bf16(g1[2], g1[3]); *(u32x2*)(Gb + (size_t)(g * 64 + 1) * DFF + j) = w;
    }
}

template <bool TWO, class F>
__device__ __forceinline__ void thin_tiles(const bf16_t* A0, const bf16_t* B0, const bf16_t* A1, const bf16_t* B1, int lda, int ldb, int K, int G, F&& epi) {
    const int lane = threadIdx.x & 63, wave = threadIdx.x >> 6, fr = lane & 15, fq = lane >> 4;
    constexpr int NTN = DM / 16;
    for (int t = wave * G + blockIdx.x; t < (MS / 16) * NTN; t += NWAVES * G) {
        const int tm = t / NTN, tn = t - tm * NTN, row0 = MP + 16 * tm, col0 = 16 * tn;
        const size_t ao = (size_t)(row0 + fr) * lda + 8 * fq, bo = (size_t)(col0 + fr) * ldb + 8 * fq;
        f32x4 acc0 = (f32x4){0.f, 0.f, 0.f, 0.f}, acc1 = acc0;
        for (int k = 0; k < K; k += 256) {
            bf16x8 av[8], bv[8], av1[8], bv1[8];
#pragma unroll
            for (int i = 0; i < 8; ++i) { av[i] = *(const bf16x8*)(A0 + ao + k + 32 * i); bv[i] = *(const bf16x8*)(B0 + bo + k + 32 * i);
                if (TWO) { av1[i] = *(const bf16x8*)(A1 + ao + k + 32 * i); bv1[i] = *(const bf16x8*)(B1 + bo + k + 32 * i); } }
#pragma unroll
            for (int i = 0; i < 8; ++i) { acc0 = __builtin_amdgcn_mfma_f32_16x16x32_bf16(bv[i], av[i], acc0, 0, 0, 0);
                if (TWO) acc1 = __builtin_amdgcn_mfma_f32_16x16x32_bf16(bv1[i], av1[i], acc1, 0, 0, 0); }
        }
        epi(row0 + fr, col0 + 4 * fq, acc0, acc1);
    }
}

constexpr int NPHASE = 12;
__global__ void __launch_bounds__(NTHR, 2) hawk_fwd(Args args) {
    extern __shared__ __attribute__((aligned(16))) unsigned char lds_raw[];
    LAS unsigned char* lds = (LAS unsigned char*)lds_raw;
    const int G = gridDim.x, lo = args.ph_lo, hi = args.ph_hi;
    unsigned char* ws = args.ws;
#ifndef ONLY_PHASE
#define ONLY_PHASE -1
#endif
#define IN(k) (lo <= (k) && (k) < hi && (ONLY_PHASE < 0 || ONLY_PHASE == (k)))
    volatile LAS unsigned* bst = (volatile LAS unsigned*)(lds + 131072);
    if (threadIdx.x < 2) bst[threadIdx.x] = 0u;
    __syncthreads();
    const XcdBarrier xbar = xcd_barrier_post((unsigned*)(ws + WS_BAR), bst);
#define SEAM(k) do { if (IN(k) && IN((k) + 1)) { if (hi > NPHASE) cg::this_grid().sync(); else xcd_barrier(xbar); } } while (0)
    if (IN(0)) { p0_prologue(args, lds, G, false); }
    SEAM(0);
    if (IN(1)) {
        pg8::Gemm g{(const bf16_t*)(ws + WS_XB), nullptr, (const bf16_t*)(ws + WS_WIN), DM, DM, DM, 1 << 30, 0};
        pg8::StaticOrder S; S.init(MTOT, INW, G, (int)blockIdx.x);
        pg8::EpiProj E{ws, args.out, args.in[I_BG], args.in[I_RCW], args.in[I_RCB], args.in[I_SRC]};
        pg8::gemm_phase<pg8::EpiProj, pg8::StaticOrder, true, true>(lds, g, S, E);
    }
    SEAM(1);
    if (IN(2)) { conv_fix(args, G); }
    SEAM(2);
    if (IN(3)) {
        pg8::Gemm g{(const bf16_t*)(ws + WS_UC), nullptr, (const bf16_t*)(ws + WS_WG), DM, RB, RB, 1 << 30, RB};
        pg8::StaticOrder S; S.init(MTOT, NRB * 256, G, (int)blockIdx.x);
        bf16_t* LA = (bf16_t*)args.out;
        pg8::EpiGates E{(const bf16_t*)(ws + WS_UC), LA, LA + (size_t)MTOT * DM, args.in[I_GAB], args.in[I_GXB], args.in[I_LAM]};
        pg8::gemm_phase<pg8::EpiGates, pg8::StaticOrder, true, true>(lds, g, S, E);
    }
    SEAM(3);
    if (IN(4)) scan_agg(args, G);
    SEAM(4);
    if (IN(5)) { scan_carry(args, G); p0_prologue(args, lds, G, true); }
    SEAM(5);
    if (IN(6)) {
        if (blockIdx.x & 1) { attn_phase(args, lds, G); scan_full(args, G); } else { scan_full(args, G); attn_phase(args, lds, G); }
    }
    SEAM(6);
    if (IN(7)) {
        pg8::Gemm g{(const bf16_t*)(ws + WS_YR), nullptr, (const bf16_t*)(ws + WS_WMIX), DM, 2048, 2048, 1 << 30, 0, (const bf16_t*)(ws + WS_YA), 16};
        { bf16_t* MIX = (bf16_t*)(ws + WS_MIX); const bf16_t* GT = (const bf16_t*)(ws + WS_GT);
          thin_tiles<true>((const bf16_t*)(ws + WS_YR), (const bf16_t*)(ws + WS_WMIX), (const bf16_t*)(ws + WS_YA), (const bf16_t*)(ws + WS_WMIX) + DM, DM, 2048, DM, G,
            [&](int row, int col, const f32x4& a0, const f32x4& a1) { const u32x2 gr = *(const u32x2*)(GT + (size_t)row * 2048 + col), ga = *(const u32x2*)(GT + (size_t)row * 2048 + 1024 + col);
                u32x2 w; w.x = cvt_pk_bf16(bf_lo(gr.x) * a0[0] + bf_lo(ga.x) * a1[0], bf_hi(gr.x) * a0[1] + bf_hi(ga.x) * a1[1]); w.y = cvt_pk_bf16(bf_lo(gr.y) * a0[2] + bf_lo(ga.y) * a1[2], bf_hi(gr.y) * a0[3] + bf_hi(ga.y) * a1[3]);
                *(u32x2*)(MIX + (size_t)row * DM + col) = w; }); }
        pg8::StaticOrder S; S.init(MP, DM, G, (int)blockIdx.x);
        pg8::EpiMix2 E{(bf16_t*)(ws + WS_MIX), (const bf16_t*)(ws + WS_GT)};
        pg8::gemm_phase<pg8::EpiMix2, pg8::StaticOrder, true, true>(lds, g, S, E);
    }
    SEAM(7);
    if (IN(8)) {
        pg8::Gemm g{(const bf16_t*)(ws + WS_MIX), nullptr, (const bf16_t*)(ws + WS_WOUT), DM, DM, DM, 1 << 30, 0};
        { const float* xs = args.in[I_XS]; float* OUTY = args.out; bf16_t* X1B = (bf16_t*)(ws + WS_X1B); float* rss2 = (float*)(ws + WS_RSS2);
          thin_tiles<false>((const bf16_t*)(ws + WS_MIX), (const bf16_t*)(ws + WS_WOUT), nullptr, nullptr, DM, DM, DM, G,
            [&](int row, int col, const f32x4& a0, const f32x4&) { const f32x4 o = *(const f32x4*)(xs + (size_t)(row - MP) * DM + col) + a0;
                u32x2 w; w.x = cvt_pk_bf16(o[0], o[1]); w.y = cvt_pk_bf16(o[2], o[3]); *(u32x2*)(X1B + (size_t)row * DM + col) = w;
                float ss = (o[0] * o[0] + o[1] * o[1]) + (o[2] * o[2] + o[3] * o[3]); ss += __shfl_xor(ss, 16); ss += __shfl_xor(ss, 32); if ((threadIdx.x & 48) == 0) atomicAdd(rss2 + row, ss); }); }
        pg8::StaticOrder S; S.init(MP, DM, G, (int)blockIdx.x);
        pg8::EpiOut E{args.in[I_XP], args.in[I_XS], args.out, (bf16_t*)(ws + WS_X1B), (float*)(ws + WS_RSS2)};
        pg8::gemm_phase<pg8::EpiOut, pg8::StaticOrder, true, true>(lds, g, S, E);
    }
    SEAM(8);
    if (IN(9)) {
        pg8::Gemm g{(const bf16_t*)(ws + WS_X1B), nullptr, (const bf16_t*)(ws + WS_WUP), DM, DM, DM, 1 << 30, 0};
        pg8::StaticOrder S; S.init(MTOT, UPW, G, (int)blockIdx.x);
        pg8::EpiUpF E{(bf16_t*)(ws + WS_G), (const float*)(ws + WS_RSS2), args.in[I_FCW], args.in[I_FCB], args.in[I_SFC], args.out, (float*)(ws + WS_HALO), (float*)(ws + WS_FIXA), (float*)(ws + WS_FIXB)};
        pg8::gemm_phase<pg8::EpiUpF, pg8::StaticOrder, true, true>(lds, g, S, E);
    }
    SEAM(9);
    if (IN(10)) ffn_fix(args, G);
    SEAM(10);
    if (IN(11)) {
        pg8::Gemm g{(const bf16_t*)(ws + WS_G), nullptr, (const bf16_t*)(ws + WS_WDN), DFF, DFF, DFF, 1 << 30, 0};
        { float* OUTY = args.out;
          thin_tiles<false>((const bf16_t*)(ws + WS_G), (const bf16_t*)(ws + WS_WDN), nullptr, nullptr, DFF, DFF, DFF, G,
            [&](int row, int col, const f32x4& a0, const f32x4&) { const u32x2 xw = *(const u32x2*)((const bf16_t*)(ws + WS_X1B) + (size_t)row * DM + col);
                *(f32x4*)(OUTY + (size_t)row * DM + col) = (f32x4){bf_lo(xw.x), bf_hi(xw.x), bf_lo(xw.y), bf_hi(xw.y)} + a0; }); }
        pg8::StaticOrder S; S.init(MP, DM, G, (int)blockIdx.x);
        pg8::EpiDown E{args.out, (const bf16_t*)(ws + WS_X1B)};
        pg8::gemm_phase<pg8::EpiDown, pg8::StaticOrder, true, true>(lds, g, S, E);
    }
#undef IN
#undef SEAM
}

extern "C" void kernel_launch(void* const* d_in, const int* in_sizes, int n_in, void* d_out, int out_size, void* d_ws, size_t ws_size, hipStream_t stream) {
    static int grid = 0;
    if (grid == 0) {
        if (n_in != 28 || (size_t)out_size != O_END || ws_size < WS_END2) { fprintf(stderr, "kernel_launch: unexpected sizes: n_in %d out %d ws %zu (need %zu)\n", n_in, out_size, ws_size, (size_t)WS_END2); grid = -1; return; }
        int dev = 0, cus = 0, per_cu = 0;
        hipGetDevice(&dev); hipDeviceGetAttribute(&cus, hipDeviceAttributeMultiprocessorCount, dev);
        if (hipFuncSetAttribute((const void*)hawk_fwd, hipFuncAttributeMaxDynamicSharedMemorySize, LDS_BYTES) != hipSuccess) { fprintf(stderr, "kernel_launch: hipFuncSetAttribute failed\n"); grid = -1; return; }
        if (hipOccupancyMaxActiveBlocksPerMultiprocessor(&per_cu, (const void*)hawk_fwd, NTHR, LDS_BYTES) != hipSuccess || per_cu < 1) { fprintf(stderr, "kernel_launch: occupancy query says %d\n", per_cu); per_cu = 1; }
        (void)hipGetLastError();
        grid = cus;
    }
    if (grid < 0) return;
    if (hipMemsetAsync((char*)d_ws + WS_BAR, 0, XCD_BAR_WORDS * 4, stream) != hipSuccess) { fprintf(stderr, "kernel_launch: memset failed\n"); return; }
    Args a{};
    for (int i = 0; i < 28; ++i) a.in[i] = (const float*)d_in[i];
    a.out = (float*)d_out; a.ws = (unsigned char*)d_ws;
#if ONE_LAUNCH
    a.ph_lo = 0; a.ph_hi = NPHASE;
    void* kargs[] = {&a};
    hipError_t e = hipLaunchCooperativeKernel((const void*)hawk_fwd, dim3(grid), dim3(NTHR), kargs, LDS_BYTES, stream);
    if (e != hipSuccess) fprintf(stderr, "kernel_launch: cooperative launch failed: %s (grid %d)\n", hipGetErrorString(e), grid);
#else
    for (int p = 0; p < NPHASE; ++p) { a.ph_lo = p; a.ph_hi = p + 1; hipLaunchKernelGGL(hawk_fwd, dim3(grid), dim3(NTHR), LDS_BYTES, stream, a); }
#endif
}
```
